# Optimizing an MI355X kernel written in HIP

```python
import jax
import jax.numpy as jnp
from jax import lax
import numpy as np

D_MODEL = 1024
BATCH = 1
SEQ = 16384
DEPTH = 2

GRID_W = 64
CTX_LEN = 256
CHUNK = 128
EPS = 1e-6
ROPE_THETA = 10000.0
N_MOD = 9

A_WIDTH = D_MODEL // 2
A_GROUPS = 8
A_GROUP_DIM = A_WIDTH // A_GROUPS
ATT_HEADS = 8
ATT_KV_HEADS = 2
ATT_GROUP = ATT_HEADS // ATT_KV_HEADS
ATT_HEAD_DIM = (D_MODEL // 2) // ATT_HEADS
ATT_Q = ATT_HEADS * ATT_HEAD_DIM
ATT_KV = ATT_KV_HEADS * ATT_HEAD_DIM
EVEN_IN = 2 * A_WIDTH + ATT_Q + 2 * ATT_KV
EVEN_CAT = A_WIDTH + ATT_Q

ML_HEADS = 8
ML_QK_DIM = (D_MODEL // 2) // ML_HEADS
ML_V_DIM = D_MODEL // ML_HEADS
ML_QK = ML_HEADS * ML_QK_DIM
ML_V = ML_HEADS * ML_V_DIM
CONV_WIDTH = 3
ODD_IN = 2 * ML_QK + 2 * ML_V + 4 * ML_HEADS

FFN_HIDDEN = ((8 * D_MODEL // 3 + 127) // 128) * 128
N_EVEN = (DEPTH + 1) // 2
N_ODD = DEPTH // 2

kernel_name = "hybrid_gmlp_gqa_mlstm_dit_trunk"


def rmsnorm(x, g):
    xf = x.astype(jnp.float32)
    y = xf * lax.rsqrt(jnp.mean(xf * xf, axis=-1, keepdims=True) + EPS)
    return (y * g.astype(jnp.float32)).astype(x.dtype)


def modulate(z, g, shift, scale):
    return rmsnorm(z, g) * (1 + scale) + shift


def swiglu(z, w13, w2):
    gate, up = jnp.split(z @ w13, 2, axis=-1)
    return (jax.nn.silu(gate) * up) @ w2


def axial_rope_angles(n_tokens):
    rows = n_tokens // GRID_W
    axis_dim = ATT_HEAD_DIM // 2
    inv_freq = ROPE_THETA ** (-jnp.arange(0, axis_dim, 2, dtype=jnp.float32) / axis_dim)
    row = jnp.broadcast_to(jnp.arange(rows, dtype=jnp.float32)[:, None], (rows, GRID_W)).reshape(-1)
    col = jnp.broadcast_to(jnp.arange(GRID_W, dtype=jnp.float32)[None, :], (rows, GRID_W)).reshape(-1)
    return row[:, None] * inv_freq, col[:, None] * inv_freq


def rotate(x, ang):
    x1, x2 = jnp.split(x, 2, axis=-1)
    cos = jnp.cos(ang)[None, :, None, :].astype(x.dtype)
    sin = jnp.sin(ang)[None, :, None, :].astype(x.dtype)
    return jnp.concatenate([x1 * cos - x2 * sin, x2 * cos + x1 * sin], axis=-1)


def axial_rope(x, ang_row, ang_col):
    xr, xc = jnp.split(x, 2, axis=-1)
    return jnp.concatenate([rotate(xr, ang_row), rotate(xc, ang_col)], axis=-1)


def chunk_spatial_gate(u, v, norm_g, w_s, b_s):
    b, t, _ = v.shape
    vn = rmsnorm(v.reshape(b, t, A_GROUPS, A_GROUP_DIM), norm_g.reshape(A_GROUPS, A_GROUP_DIM))
    vn = vn.reshape(b, t // CHUNK, CHUNK, A_GROUPS, A_GROUP_DIM)
    s = jnp.einsum('gts,bnsgd->bntgd', w_s, vn) + b_s.T[None, None, :, :, None]
    return u * s.reshape(b, t, A_WIDTH)


def gqa_attend(q, k, v):
    b, nq = q.shape[0], q.shape[1]
    qg = q.reshape(b, nq, ATT_KV_HEADS, ATT_GROUP, ATT_HEAD_DIM)
    s = jnp.einsum('bqkgd,bskd->bkgqs', qg, k).astype(jnp.float32) * (ATT_HEAD_DIM ** -0.5)
    p = jax.nn.softmax(s, axis=-1).astype(v.dtype)
    return jnp.einsum('bkgqs,bskd->bqkgd', p, v).reshape(b, nq, ATT_Q)


def gqa_blocks(q, k, v):
    b, t = q.shape[0], q.shape[1]
    qb = jnp.swapaxes(q.reshape(b, t // CHUNK, CHUNK, ATT_HEADS, ATT_HEAD_DIM), 0, 1)
    out = lax.map(lambda qq: gqa_attend(qq, k, v), qb)
    return jnp.swapaxes(out, 0, 1).reshape(b, t, ATT_Q)


def gmlp_gqa_mixer(z_lat, z_ctx, w_in, gate_norm_g, sp_w, sp_b, q_norm_g, k_norm_g, w_out,
                   ang_row, ang_col, ctx_out):
    def project(z):
        p = z @ w_in
        b, t, _ = p.shape
        u = jax.nn.gelu(p[..., :A_WIDTH])
        v = jax.nn.gelu(p[..., A_WIDTH:2 * A_WIDTH])
        o = 2 * A_WIDTH
        q = rmsnorm(p[..., o:o + ATT_Q].reshape(b, t, ATT_HEADS, ATT_HEAD_DIM), q_norm_g)
        k = rmsnorm(p[..., o + ATT_Q:o + ATT_Q + ATT_KV].reshape(b, t, ATT_KV_HEADS, ATT_HEAD_DIM), k_norm_g)
        va = p[..., o + ATT_Q + ATT_KV:].reshape(b, t, ATT_KV_HEADS, ATT_HEAD_DIM)
        return u, v, q, k, va

    u_l, v_l, q_l, k_l, a_l = project(z_lat)
    u_c, v_c, q_c, k_c, a_c = project(z_ctx)
    q_l = axial_rope(q_l, ang_row, ang_col)
    k_l = axial_rope(k_l, ang_row, ang_col)
    k_all = jnp.concatenate([k_c, k_l], axis=1)
    a_all = jnp.concatenate([a_c, a_l], axis=1)
    y_lat = jnp.concatenate([chunk_spatial_gate(u_l, v_l, gate_norm_g, sp_w, sp_b),
                             gqa_blocks(q_l, k_all, a_all)], axis=-1) @ w_out
    if not ctx_out:
        return y_lat, None
    y_ctx = jnp.concatenate([chunk_spatial_gate(u_c, v_c, gate_norm_g, sp_w, sp_b),
                             gqa_attend(q_c, k_c, a_c)], axis=-1) @ w_out
    return y_lat, y_ctx


def short_conv(x, w):
    pad = CONV_WIDTH // 2
    t = x.shape[1]
    xp = jnp.pad(x, ((0, 0), (pad, pad), (0, 0)))
    y = xp[:, 0:t] * w[0]
    for j in range(1, CONV_WIDTH):
        y = y + xp[:, j:j + t] * w[j]
    return y


def to_chunks(t):
    b, n = t.shape[0], t.shape[1] // CHUNK
    t = t.reshape((b, n, CHUNK) + t.shape[2:])
    return jnp.moveaxis(t, 3, 1)


def from_chunks(t):
    t = jnp.moveaxis(t, 1, 3)
    return t.reshape((t.shape[0], t.shape[1] * t.shape[2]) + t.shape[3:])


def mlstm_chunk_states(k, v, log_i, log_f, state0):
    b_cum = jnp.cumsum(log_f, axis=-1)
    b_last = b_cum[..., -1]
    w = b_last[..., None] - b_cum + log_i
    m_loc = jnp.max(w, axis=-1)
    e = jnp.exp(w - m_loc[..., None])
    c_loc = jnp.einsum('bhnl,bhnlv,bhnlk->bhnvk', e, v, k)
    n_loc = jnp.einsum('bhnl,bhnlk->bhnk', e, k)

    def step(carry, inp):
        c_prev, n_prev, m_prev = carry
        cl, nl, ml, bl = inp
        m_new = jnp.maximum(bl + m_prev, ml)
        a = jnp.exp(bl + m_prev - m_new)
        g = jnp.exp(ml - m_new)
        c_new = a[..., None, None] * c_prev + g[..., None, None] * cl
        n_new = a[..., None] * n_prev + g[..., None] * nl
        return (c_new, n_new, m_new), (c_prev, n_prev, m_prev)

    xs = (jnp.moveaxis(c_loc, 2, 0), jnp.moveaxis(n_loc, 2, 0),
          jnp.moveaxis(m_loc, 2, 0), jnp.moveaxis(b_last, 2, 0))
    final, (c_in, n_in, m_in) = lax.scan(step, state0, xs)
    return jnp.moveaxis(c_in, 0, 2), jnp.moveaxis(n_in, 0, 2), jnp.moveaxis(m_in, 0, 2), final


def mlstm_chunk_outputs(q, k, v, log_i, log_f, c_in, n_in, m_in):
    b_cum = jnp.cumsum(log_f, axis=-1)
    ln = q.shape[-2]
    lower = jnp.tril(jnp.ones((ln, ln), dtype=bool))
    dmat = b_cum[..., :, None] - b_cum[..., None, :] + log_i[..., None, :]
    dmat = jnp.where(lower, dmat, -jnp.inf)
    inter = b_cum + m_in[..., None]
    m = jnp.maximum(inter, jnp.max(dmat, axis=-1))
    wts = jnp.exp(dmat - m[..., None])
    a = jnp.exp(inter - m)
    s = jnp.einsum('bhnjd,bhnsd->bhnjs', q, k) * wts
    num = jnp.einsum('bhnjs,bhnsv->bhnjv', s, v) + a[..., None] * jnp.einsum('bhnvk,bhnjk->bhnjv', c_in, q)
    den = jnp.sum(s, axis=-1) + a * jnp.einsum('bhnk,bhnjk->bhnj', n_in, q)
    return num / jnp.maximum(jnp.abs(den), jnp.exp(-m))[..., None]


def mlstm_mixer(z_lat, z_ctx, w_in, conv_w, gate_b, out_norm_g, w_out, ctx_out):
    def project(z):
        p = z @ w_in
        b, t, _ = p.shape
        qk = jax.nn.silu(short_conv(p[..., :2 * ML_QK], conv_w)).astype(jnp.float32)
        q = qk[..., :ML_QK].reshape(b, t, ML_HEADS, ML_QK_DIM) * (ML_QK_DIM ** -0.5)
        k = qk[..., ML_QK:].reshape(b, t, ML_HEADS, ML_QK_DIM)
        v = p[..., 2 * ML_QK:2 * ML_QK + ML_V].reshape(b, t, ML_HEADS, ML_V_DIM).astype(jnp.float32)
        o = p[..., 2 * ML_QK + ML_V:2 * ML_QK + 2 * ML_V]
        g = (p[..., 2 * ML_QK + 2 * ML_V:] + gate_b).astype(jnp.float32).reshape(b, t, 4, ML_HEADS)
        return q, k, v, o, g

    lat = project(z_lat)
    ctx = project(z_ctx)
    bsz = z_lat.shape[0]
    zero = (jnp.zeros((bsz, ML_HEADS, ML_V_DIM, ML_QK_DIM), jnp.float32),
            jnp.zeros((bsz, ML_HEADS, ML_QK_DIM), jnp.float32),
            jnp.zeros((bsz, ML_HEADS), jnp.float32))

    def run_direction(d):
        def orient(t):
            return jnp.flip(t, axis=1) if d == 1 else t

        def chunked(side):
            q, k, v, _, g = side
            log_i = g[:, :, 2 * d]
            log_f = jax.nn.log_sigmoid(g[:, :, 2 * d + 1])
            return tuple(to_chunks(orient(t)) for t in (q, k, v, log_i, log_f))

        qc, kc, vc, ic, fc = chunked(ctx)
        ql, kl, vl, il, fl = chunked(lat)
        cc_in, nc_in, mc_in, ctx_final = mlstm_chunk_states(kc, vc, ic, fc, zero)
        cl_in, nl_in, ml_in, _ = mlstm_chunk_states(kl, vl, il, fl, ctx_final)
        h_lat = orient(from_chunks(mlstm_chunk_outputs(ql, kl, vl, il, fl, cl_in, nl_in, ml_in)))
        h_ctx = orient(from_chunks(mlstm_chunk_outputs(qc, kc, vc, ic, fc, cc_in, nc_in, mc_in))) if ctx_out else None
        return h_lat, h_ctx

    hf_lat, hf_ctx = run_direction(0)
    hb_lat, hb_ctx = run_direction(1)

    def readout(h, o):
        b, t = h.shape[0], h.shape[1]
        hn = rmsnorm(h, out_norm_g.reshape(ML_HEADS, ML_V_DIM)).reshape(b, t, ML_V).astype(o.dtype)
        return (hn * jax.nn.sigmoid(o)) @ w_out

    y_lat = readout(hf_lat + hb_lat, lat[3])
    y_ctx = readout(hf_ctx + hb_ctx, ctx[3]) if ctx_out else None
    return y_lat, y_ctx


def setup_inputs(seed: int = 0) -> dict:
    key = jax.random.key(seed)
    ks = jax.random.split(key, 24)

    def nrm(k, shape, scale=1.0):
        return jax.random.normal(k, shape, jnp.float32) * scale

    d, f = D_MODEL, FFN_HIDDEN
    gi = nrm(ks[18], (N_ODD, 2, ML_HEADS), 0.1)
    gf = jnp.linspace(3.0, 6.0, ML_HEADS, dtype=jnp.float32) + nrm(ks[19], (N_ODD, 2, ML_HEADS), 0.1)
    ml_gate_b = jnp.stack([gi[:, 0], gf[:, 0], gi[:, 1], gf[:, 1]], axis=1).reshape(N_ODD, 4 * ML_HEADS)
    return {
        "x": nrm(ks[0], (BATCH, SEQ, d)),
        "c": nrm(ks[1], (BATCH, d)),
        "ctx": nrm(ks[2], (BATCH, CTX_LEN, d)),
        "c_ctx": nrm(ks[3], (d,)),
        "mod_w": nrm(ks[4], (DEPTH, d, N_MOD * d), 0.5 * d ** -0.5),
        "mod_b": nrm(ks[5], (DEPTH, N_MOD * d), 0.1),
        "norm_g": 1.0 + nrm(ks[6], (DEPTH, 3, d), 0.1),
        "ffn_w13": nrm(ks[7], (DEPTH, 2, d, 2 * f), d ** -0.5),
        "ffn_w2": nrm(ks[8], (DEPTH, 2, f, d), f ** -0.5),
        "ab_w_in": nrm(ks[9], (N_EVEN, d, EVEN_IN), d ** -0.5),
        "ab_gate_norm_g": 1.0 + nrm(ks[10], (N_EVEN, A_WIDTH), 0.1),
        "ab_spatial_w": nrm(ks[11], (N_EVEN, A_GROUPS, CHUNK, CHUNK), CHUNK ** -0.5),
        "ab_spatial_b": 1.0 + nrm(ks[12], (N_EVEN, A_GROUPS, CHUNK), 0.1),
        "ab_q_norm_g": 1.0 + nrm(ks[13], (N_EVEN, ATT_HEAD_DIM), 0.1),
        "ab_k_norm_g": 1.0 + nrm(ks[14], (N_EVEN, ATT_HEAD_DIM), 0.1),
        "ab_w_out": nrm(ks[15], (N_EVEN, EVEN_CAT, d), EVEN_CAT ** -0.5),
        "ml_w_in": nrm(ks[16], (N_ODD, d, ODD_IN), d ** -0.5),
        "ml_conv_w": nrm(ks[17], (N_ODD, CONV_WIDTH, 2 * ML_QK), CONV_WIDTH ** -0.5),
        "ml_gate_b": ml_gate_b,
        "ml_out_norm_g": 1.0 + nrm(ks[20], (N_ODD, ML_V), 0.1),
        "ml_w_out": nrm(ks[21], (N_ODD, ML_V, d), ML_V ** -0.5),
        "final_norm_g": 1.0 + nrm(ks[22], (d,), 0.1),
    }


def reference(x, c, ctx, c_ctx, mod_w, mod_b, norm_g, ffn_w13, ffn_w2,
              ab_w_in, ab_gate_norm_g, ab_spatial_w, ab_spatial_b, ab_q_norm_g, ab_k_norm_g, ab_w_out,
              ml_w_in, ml_conv_w, ml_gate_b, ml_out_norm_g, ml_w_out, final_norm_g):
    b, t, d = x.shape
    ang_row, ang_col = axial_rope_angles(t)
    s_lat = jax.nn.silu(c)
    s_ctx = jax.nn.silu(c_ctx)[None, :]
    h, hc = x, ctx
    for l in range(DEPTH):
        keep_ctx = l < DEPTH - 1
        m_l = (s_lat @ mod_w[l] + mod_b[l]).reshape(b, N_MOD, 1, d)
        m_c = (s_ctx @ mod_w[l] + mod_b[l]).reshape(1, N_MOD, 1, d)
        h = h + 0.5 * m_l[:, 2] * swiglu(modulate(h, norm_g[l, 0], m_l[:, 0], m_l[:, 1]), ffn_w13[l, 0], ffn_w2[l, 0])
        hc = hc + 0.5 * m_c[:, 2] * swiglu(modulate(hc, norm_g[l, 0], m_c[:, 0], m_c[:, 1]), ffn_w13[l, 0], ffn_w2[l, 0])
        z_l = modulate(h, norm_g[l, 1], m_l[:, 3], m_l[:, 4])
        z_c = modulate(hc, norm_g[l, 1], m_c[:, 3], m_c[:, 4])
        if l % 2 == 0:
            e = l // 2
            y_l, y_c = gmlp_gqa_mixer(z_l, z_c, ab_w_in[e], ab_gate_norm_g[e], ab_spatial_w[e], ab_spatial_b[e],
                                      ab_q_norm_g[e], ab_k_norm_g[e], ab_w_out[e], ang_row, ang_col, keep_ctx)
        else:
            o = l // 2
            y_l, y_c = mlstm_mixer(z_l, z_c, ml_w_in[o], ml_conv_w[o], ml_gate_b[o], ml_out_norm_g[o],
                                   ml_w_out[o], keep_ctx)
        h = h + m_l[:, 5] * y_l
        h = h + 0.5 * m_l[:, 8] * swiglu(modulate(h, norm_g[l, 2], m_l[:, 6], m_l[:, 7]), ffn_w13[l, 1], ffn_w2[l, 1])
        if keep_ctx:
            hc = hc + m_c[:, 5] * y_c
            hc = hc + 0.5 * m_c[:, 8] * swiglu(modulate(hc, norm_g[l, 2], m_c[:, 6], m_c[:, 7]), ffn_w13[l, 1], ffn_w2[l, 1])
    return rmsnorm(h, final_norm_g)
```

```cpp
#include <hip/hip_runtime.h>
#include <hip/hip_cooperative_groups.h>
#include <cstdio>
#include <cstdint>
namespace cg = cooperative_groups;

typedef unsigned short u16;
typedef short bf16x8 __attribute__((ext_vector_type(8)));
typedef float f32x4 __attribute__((ext_vector_type(4)));
typedef unsigned u32x4 __attribute__((ext_vector_type(4)));
typedef unsigned u32x2 __attribute__((ext_vector_type(2)));
#define DEV __device__ __forceinline__

constexpr int D = 1024, NCTX = 256, NLAT = 16384, R = NCTX + NLAT;
constexpr int FH = 2816, F2 = 5632;
constexpr int EVEN_IN = 1792, ODD_IN = 3104, ODD_PAD = 3328, PMW = 3072;
constexpr int NPC = R / 128;
constexpr int NITEM = 2 * 8 * NPC;
constexpr float EPS = 1e-6f;
constexpr float C2 = 0.125f * 1.4426950408889634f;
constexpr int NWAVES = 8, NTHR = 512;
constexpr int LDS_BYTES = 147456;
#ifndef NFUSE
#define NFUSE 1
#endif
#ifndef FIXEDREF
#define FIXEDREF 1
#endif
#ifndef PREP_DEFER
#define PREP_DEFER 1
#endif
#ifndef KSPLIT
#define KSPLIT 1
#endif
#ifndef PROBE_REP
#define PROBE_REP 0
#endif
#define REPN(bit) for (int rep_ = 0; rep_ < ((PROBE_REP & (bit)) ? 2 : 1); ++rep_)
#ifndef FASTM
#define FASTM 7
#endif
#ifndef FASTA
#define FASTA 1
#endif
#ifndef FASTG
#define FASTG 31
#endif

constexpr size_t KiB = 1024, MiB = 1u << 20;
constexpr size_t WS_MV = 0;
constexpr size_t WS_BAR = 192 * KiB;
constexpr size_t WS_MISC = 256 * KiB;
constexpr size_t WS_GS = 1 * MiB;
constexpr size_t WS_G = 5 * MiB + 256 * KiB;
constexpr size_t WS_W13T = 7 * MiB + 512 * KiB;
constexpr size_t WS_W2T = WS_W13T + 44 * MiB;
constexpr size_t WS_ABIN = WS_W2T + 22 * MiB;
constexpr size_t WS_ABOUT = WS_ABIN + 3 * MiB + 512 * KiB;
constexpr size_t WS_MLIN = WS_ABOUT + 2 * MiB;
constexpr size_t WS_MLOUT = WS_MLIN + 6 * MiB + 512 * KiB;
constexpr size_t WS_SPW = WS_MLOUT + 2 * MiB;
constexpr size_t WS_H = WS_SPW + 256 * KiB;
constexpr size_t WS_XN = WS_H + 65 * MiB;
constexpr size_t WS_BIG = WS_XN + 32 * MiB + 512 * KiB;
constexpr size_t WS_CLOC = WS_BIG + 97 * MiB + 512 * KiB;
constexpr size_t WS_END = WS_CLOC + 65 * MiB;
constexpr size_t WS_RSS = WS_END;
constexpr size_t WS_RSS_BYTES = 6 * (size_t)16640 * 8;
static_assert(WS_RSS + WS_RSS_BYTES <= 352 * MiB, "ws map");

struct Args { const float* in[22]; float* out; unsigned char* ws; int ph_lo, ph_hi; };

DEV float bf2f(u16 v) { return __uint_as_float((unsigned)v << 16); }
DEV u16 f2bf(float f) { unsigned u = __float_as_uint(f); return (u16)((u + 0x7fffu + ((u >> 16) & 1u)) >> 16); }
DEV unsigned pk2(float lo, float hi) { return (unsigned)f2bf(lo) | ((unsigned)f2bf(hi) << 16); }
DEV float silu_f(float x) { return x / (1.f + __expf(-x)); }
DEV float sigmoid_f(float x) { return 1.f / (1.f + __expf(-x)); }
DEV float gelu_tanh(float x) { const float u = 0.7978845608028654f * (x + 0.044715f * x * x * x); return 0.5f * x * (1.f + tanhf(u)); }
DEV float log_sigmoid_f(float x) { return fminf(x, 0.f) - log1pf(__expf(-fabsf(x))); }
DEV float wave_sum(float v) {
#pragma unroll
    for (int o = 1; o < 64; o <<= 1) v += __shfl_xor(v, o);
    return v;
}
#define LDS_FENCE() asm volatile("s_waitcnt lgkmcnt(0)" ::: "memory")
DEV int tid_fresh() { int t = threadIdx.x; asm volatile("" : "+v"(t)); return t; }

struct Ctx {
    const float *x, *c, *ctx, *c_ctx, *mod_w, *mod_b, *norm_g, *ffn_w13, *ffn_w2, *ab_w_in, *ab_gate_norm_g, *ab_spatial_w, *ab_spatial_b,
        *ab_q_norm_g, *ab_k_norm_g, *ab_w_out, *ml_w_in, *ml_conv_w, *ml_gate_b, *ml_out_norm_g, *ml_w_out, *final_norm_g;
    float* out;
    float *ROPE, *MV, *MLOC, *BLAST, *MIN, *NLOC, *BB, *LI, *EE, *RM, *G, *H, *CLOC;
    u16 *W13T, *W2T, *ABIN, *ABOUT, *MLIN, *MLOUT, *SPW, *XN, *BIG, *RAW;
    int tid, lane, wave, gw, NGW, gtid, NT;
    unsigned char* lds;
};

DEV int maprow(int type, int n0) {
    if (type == 1) { if (n0 < FH) return 256 * (n0 / 128) + (n0 % 128); const int j = n0 - FH; return 256 * (j / 128) + 128 + (j % 128); }
    if (type == 2) { const int a = n0 % 256, wc = a / 64, bj = (a % 64) / 32; return (n0 / 256) * 256 + 128 * bj + 32 * wc; }
    return n0;
}
DEV void transpose_item(const float* W, int K, int N, u16* WT, int type, float* scr, int item, int lane) {
    const int nblk = N / 32, kb = item / nblk, nb = item % nblk, k0 = 64 * kb, n0 = 32 * nb;
#pragma unroll 8
    for (int i = 0; i < 32; ++i) { const int kk = 2 * i + (lane >> 5); scr[kk * 33 + (lane & 31)] = W[(size_t)(k0 + kk) * N + n0 + (lane & 31)]; }
    LDS_FENCE();
    const int c = lane & 7, d0 = maprow(type, n0);
#pragma unroll
    for (int j = 0; j < 4; ++j) {
        const int n = (lane >> 3) + 8 * j; const float* s = scr + (8 * c) * 33 + n;
        u32x4 o; o.x = pk2(s[0 * 33], s[1 * 33]); o.y = pk2(s[2 * 33], s[3 * 33]); o.z = pk2(s[4 * 33], s[5 * 33]); o.w = pk2(s[6 * 33], s[7 * 33]);
        *(u32x4*)(WT + (size_t)(d0 + n) * K + k0 + 8 * c) = o;
    }
    LDS_FENCE();
}
DEV void prep_group(const Ctx& X, int grp, int widx, int nworkers) {
    float* scr = (float*)(X.lds) + X.wave * (64 * 33);
    constexpr int I13 = 16 * (F2 / 32), I2 = (FH / 64) * 32, IABI = 16 * (EVEN_IN / 32), ISQ = 16 * 32, IMLI = 16 * (ODD_IN / 32);
    const int fi = grp == 0 ? 0 : grp;
    const int nit = I13 + I2 + (grp == 1 ? IABI + ISQ : (grp == 2 ? IMLI + ISQ : 0));
    for (int it = widx; it < nit; it += nworkers) {
        int r = it;
        if (r < I13) { transpose_item(X.ffn_w13 + (size_t)fi * D * F2, D, F2, X.W13T + (size_t)fi * F2 * D, 1, scr, r, X.lane); continue; } r -= I13;
        if (r < I2) { transpose_item(X.ffn_w2 + (size_t)fi * FH * D, FH, D, X.W2T + (size_t)fi * D * FH, 0, scr, r, X.lane); continue; } r -= I2;
        if (grp == 1) { if (r < IABI) { transpose_item(X.ab_w_in, D, EVEN_IN, X.ABIN, 2, scr, r, X.lane); continue; } r -= IABI; transpose_item(X.ab_w_out, D, D, X.ABOUT, 0, scr, r, X.lane); }
        else { if (r < IMLI) { transpose_item(X.ml_w_in, D, ODD_IN, X.MLIN, 0, scr, r, X.lane); continue; } r -= IMLI; transpose_item(X.ml_w_out, D, D, X.MLOUT, 0, scr, r, X.lane); }
    }
}
DEV void phase_prep(Ctx& X) {
    if (PREP_DEFER) prep_group(X, 0, X.gw, X.NGW);
    else for (int g = 0; g < 4; ++g) prep_group(X, g, X.gw, X.NGW);
    for (int i = X.gtid; i < (ODD_PAD - ODD_IN) * D / 8; i += X.NT) *(u32x4*)(X.MLIN + (size_t)ODD_IN * D + (size_t)i * 8) = (u32x4){0u, 0u, 0u, 0u};
    for (int i = X.gtid; i < 8 * 128 * 128 / 4; i += X.NT) { const f32x4 v = *(const f32x4*)(X.ab_spatial_w + (size_t)i * 4); u32x2 o; o.x = pk2(v.x, v.y); o.y = pk2(v.z, v.w); *(u32x2*)(X.SPW + (size_t)i * 4) = o; }
    for (int i = X.gtid; i < 256 * 16; i += X.NT) { const int pos = i >> 4, k = i & 15; const float ang = (float)pos * powf(10000.f, -(float)(2 * k) / 32.f); X.ROPE[pos * 32 + k] = cosf(ang); X.ROPE[pos * 32 + 16 + k] = sinf(ang); }
    __syncthreads();
    float* sS = (float*)X.lds;
    float* red = sS + 2048;
    for (int i = X.tid; i < 1024; i += NTHR) { sS[i] = silu_f(X.c[i]); sS[1024 + i] = silu_f(X.c_ctx[i]); }
    __syncthreads();
    for (int it = blockIdx.x; it < 2 * 288; it += gridDim.x) {
        const int l = it / 288, cg0 = (it % 288) * 32, col = cg0 + (X.tid & 31), ks = X.tid >> 5;
        const float* w = X.mod_w + (size_t)l * D * 9216 + (size_t)(ks * 64) * 9216 + col;
        float a0 = 0.f, a1 = 0.f;
#pragma unroll 8
        for (int k = 0; k < 64; ++k) { const float wv = w[(size_t)k * 9216]; a0 += sS[ks * 64 + k] * wv; a1 += sS[1024 + ks * 64 + k] * wv; }
        red[(ks * 32 + (X.tid & 31)) * 2] = a0; red[(ks * 32 + (X.tid & 31)) * 2 + 1] = a1;
        __syncthreads();
        if (X.tid < 64) {
            const int cc = X.tid & 31, w2 = X.tid >> 5; float s = 0.f;
            for (int k = 0; k < 16; ++k) s += red[(k * 32 + cc) * 2 + w2];
            X.MV[(size_t)(l * 2 + w2) * 9216 + cg0 + cc] = s + X.mod_b[(size_t)l * 9216 + cg0 + cc];
        }
        __syncthreads();
    }
}

DEV const float* row_src(const Ctx& X, bool from_in, int r) { return from_in ? (r < NCTX ? X.ctx + (size_t)r * D : X.x + (size_t)(r - NCTX) * D) : X.H + (size_t)r * D; }
DEV void phase_norm(Ctx& X, int l, int i, bool from_in, int r_lo, int nks = 0, int r_hi = R) {
    const float* g = X.norm_g + (size_t)(l * 3 + i) * D;
    for (int r = r_lo + X.gw; r < r_hi; r += X.NGW) {
        const f32x4* xr = (const f32x4*)row_src(X, from_in, r) + X.lane;
        const float* mv = X.MV + (size_t)(l * 2 + (r < NCTX ? 1 : 0)) * 9216 + (size_t)(3 * i) * D;
        f32x4 v[4]; float s = 0.f;
#pragma unroll
        for (int j = 0; j < 4; ++j) v[j] = xr[64 * j];
        const bool addp = nks > 0 && r < NCTX;
        if (addp) for (int k = 0; k < nks; ++k) { const f32x4* pr = (const f32x4*)(X.CLOC + ((size_t)k * 256 + r) * D) + X.lane;
#pragma unroll
            for (int j = 0; j < 4; ++j) v[j] = v[j] + pr[64 * j]; }
#pragma unroll
        for (int j = 0; j < 4; ++j) s += (v[j].x * v[j].x + v[j].y * v[j].y) + (v[j].z * v[j].z + v[j].w * v[j].w);
        const float rs = rsqrtf(wave_sum(s) * (1.f / D) + EPS);
        if ((from_in && r < NCTX) || addp) { f32x4* hr = (f32x4*)(X.H + (size_t)r * D) + X.lane;
#pragma unroll
            for (int j = 0; j < 4; ++j) hr[64 * j] = v[j]; }
        u32x2* o = (u32x2*)(X.XN + (size_t)r * D) + X.lane;
#pragma unroll
        for (int j = 0; j < 4; ++j) {
            const int c = 4 * X.lane + 256 * j;
            const f32x4 gg = *(const f32x4*)(g + c), sh = *(const f32x4*)(mv + c), sc = *(const f32x4*)(mv + D + c);
            f32x4 y = v[j] * rs * gg * (sc + 1.f) + sh;
            u32x2 w; w.x = pk2(y.x, y.y); w.y = pk2(y.z, y.w); o[64 * j] = w;
        }
    }
}
DEV void phase_final(Ctx& X) {
    for (int t = X.gw; t < NLAT; t += X.NGW) {
        const f32x4* xr = (const f32x4*)(X.H + (size_t)(NCTX + t) * D) + X.lane;
        f32x4 v[4]; float s = 0.f;
#pragma unroll
        for (int j = 0; j < 4; ++j) { v[j] = xr[64 * j]; s += (v[j].x * v[j].x + v[j].y * v[j].y) + (v[j].z * v[j].z + v[j].w * v[j].w); }
        const float rs = rsqrtf(wave_sum(s) * (1.f / D) + EPS);
        f32x4* o = (f32x4*)(X.out + (size_t)t * D) + X.lane;
#pragma unroll
        for (int j = 0; j < 4; ++j) { const f32x4 gg = *(const f32x4*)(X.final_norm_g + 4 * X.lane + 256 * j); o[64 * j] = v[j] * rs * gg; }
    }
}

template <bool DUAL, class F>
DEV void ngemm(const Ctx& X, const u16* A, int lda, const u16* Bt, int K, int row0, int nrows, int ncols_tile, const F& f) {
    const int nrt = nrows / 32, spu = DUAL ? 4 : 8, nslots = (ncols_tile / 256) * spu, fr = X.lane & 15, fq = X.lane >> 4;
    for (long it = X.gw; it < (long)nrt * nslots; it += X.NGW) {
        const int rt = (int)(it % nrt), sl = (int)(it / nrt), u = sl / spu, s = sl % spu, n0 = u * 256 + 32 * s, r0 = row0 + rt * 32;
        f32x4 acc[2][2], acc2[2][2];
#pragma unroll
        for (int m = 0; m < 2; ++m)
#pragma unroll
            for (int n = 0; n < 2; ++n) { acc[m][n] = (f32x4){0.f, 0.f, 0.f, 0.f}; acc2[m][n] = (f32x4){0.f, 0.f, 0.f, 0.f}; }
        const u16* a0 = A + (size_t)(r0 + fr) * lda + fq * 8;
        const u16* b0 = Bt + (size_t)(n0 + fr) * K + fq * 8;
        for (int k = 0; k < K; k += 32) {
            bf16x8 a[2], b[2], c[2];
            a[0] = *(const bf16x8*)(a0 + k); a[1] = *(const bf16x8*)(a0 + (size_t)16 * lda + k);
            b[0] = *(const bf16x8*)(b0 + k); b[1] = *(const bf16x8*)(b0 + (size_t)16 * K + k);
            if (DUAL) { c[0] = *(const bf16x8*)(b0 + (size_t)128 * K + k); c[1] = *(const bf16x8*)(b0 + (size_t)144 * K + k); }
#pragma unroll
            for (int m = 0; m < 2; ++m)
#pragma unroll
                for (int n = 0; n < 2; ++n) {
                    acc[m][n] = __builtin_amdgcn_mfma_f32_16x16x32_bf16(a[m], b[n], acc[m][n], 0, 0, 0);
                    if (DUAL) acc2[m][n] = __builtin_amdgcn_mfma_f32_16x16x32_bf16(a[m], c[n], acc2[m][n], 0, 0, 0);
                }
        }
#pragma unroll
        for (int m = 0; m < 2; ++m)
#pragma unroll
            for (int n = 0; n < 2; ++n)
#pragma unroll
                for (int j = 0; j < 4; ++j) f(r0 + 16 * m + 4 * fq + j, n0 + 16 * n + fr, acc[m][n][j], acc2[m][n][j]);
    }
}
struct FSwiglu { u16* HID; DEV void operator()(int r, int p, float g, float u) const { const int col = 128 * (p / 256) + (p % 256); HID[(size_t)r * FH + col] = f2bf(silu_f(g) * u); } };
struct FResid { const Ctx* X; bool from_in; const float* mvl; const float* mvc; float mul;
    DEV void operator()(int r, int c, float v, float) const { const float b = row_src(*X, from_in, r)[c]; const float m = (r < NCTX ? mvc : mvl)[c]; X->H[(size_t)r * D + c] = b + mul * m * v; } };
struct FRawAB { u16* RAW; DEV void operator()(int r, int p, float v, float) const { const int q = p % 256, bj = q / 128, wc = (q % 128) / 32, x = q % 32; RAW[(size_t)r * EVEN_IN + (p / 256) * 256 + 64 * wc + 32 * bj + x] = f2bf(v); } };
struct FML { u16* PM; float* G; const float* gb; DEV void operator()(int r, int c, float v, float) const { if (c < PMW) PM[(size_t)r * PMW + c] = f2bf(v); else if (c < ODD_IN) G[(size_t)r * 32 + (c - PMW)] = v + gb[c - PMW]; } };

DEV void phase_abpost(Ctx& X) {
    u16* P0 = X.BIG;
    for (int it = X.gtid; it < R * 28; it += X.NT) {
        const int r = it / 28, grp = it % 28, c0 = grp * 64;
        const u16* src = X.RAW + (size_t)r * EVEN_IN + c0; u16* dst = P0 + (size_t)r * EVEN_IN + c0;
        if (grp < 8) { for (int d = 0; d < 64; ++d) dst[d] = f2bf(gelu_tanh(bf2f(src[d]))); continue; }
        if (grp >= 26) { for (int d = 0; d < 64; ++d) dst[d] = src[d]; continue; }
        float ss = 0.f;
        if (grp < 16) { for (int d = 0; d < 64; ++d) { const float v = gelu_tanh(bf2f(src[d])); ss += v * v; } const float rs = rsqrtf(ss * (1.f / 64) + EPS);
            for (int d = 0; d < 64; ++d) dst[d] = f2bf(gelu_tanh(bf2f(src[d])) * rs * X.ab_gate_norm_g[c0 - 512 + d]); continue; }
        for (int d = 0; d < 64; ++d) { const float v = bf2f(src[d]); ss += v * v; }
        const float rs = rsqrtf(ss * (1.f / 64) + EPS); const bool isq = grp < 24; const float* g = isq ? X.ab_q_norm_g : X.ab_k_norm_g; const float osc = isq ? C2 : 1.f;
        if (r < NCTX) { for (int d = 0; d < 64; ++d) dst[d] = f2bf(bf2f(src[d]) * rs * g[d] * osc); continue; }
        const int t = r - NCTX; const float pr = (float)(t / 64), pc = (float)(t % 64);
        for (int half = 0; half < 2; ++half) for (int i = 0; i < 16; ++i) {
            const float invf = __powf(10000.f, -(float)(2 * i) / 32.f), ang = (half ? pc : pr) * invf, cs = cosf(ang), sn = sinf(ang);
            const int d1 = half * 32 + i, d2 = d1 + 16; const float x1 = bf2f(src[d1]) * rs * g[d1], x2 = bf2f(src[d2]) * rs * g[d2];
            dst[d1] = f2bf((x1 * cs - x2 * sn) * osc); dst[d2] = f2bf((x2 * cs + x1 * sn) * osc);
        }
    }
}
DEV void phase_sgu_naive(Ctx& X) {
    const u16* P0 = X.BIG; u16* CAT = X.XN;
    for (int it = X.gtid; it < R * 512; it += X.NT) {
        const int r = it / 512, col = it % 512, ch = r / 128, t = r % 128, g = col / 64;
        const float* w = X.ab_spatial_w + (size_t)(g * 128 + t) * 128; float s = X.ab_spatial_b[g * 128 + t];
        for (int sp = 0; sp < 128; ++sp) s += w[sp] * bf2f(P0[(size_t)(ch * 128 + sp) * EVEN_IN + 512 + col]);
        CAT[(size_t)r * D + col] = f2bf(bf2f(P0[(size_t)r * EVEN_IN + col]) * s);
    }
}
DEV void phase_attn_naive(Ctx& X) {
    const u16* P0 = X.BIG; u16* CAT = X.XN;
    for (int it = X.gtid; it < R * 8; it += X.NT) {
        const int h = __builtin_amdgcn_readfirstlane(it / R), r = it % R, kvh = h / 4;
        const int nkeys = __builtin_amdgcn_readfirstlane(r < NCTX ? NCTX : R);
        float q[64], acc[64];
        for (int d = 0; d < 64; ++d) { q[d] = bf2f(P0[(size_t)r * EVEN_IN + 1024 + h * 64 + d]); acc[d] = 0.f; }
        float m = -1e30f, l = 0.f;
        for (int key = 0; key < nkeys; ++key) {
            const u16* kp = P0 + (size_t)key * EVEN_IN + 1536 + kvh * 64; const u16* vp = kp + 128;
            float s = 0.f;
#pragma unroll
            for (int d = 0; d < 64; ++d) s += q[d] * bf2f(kp[d]);
            if (s > m) { const float f = exp2f(m - s); l *= f;
#pragma unroll
                for (int d = 0; d < 64; ++d) acc[d] *= f;
                m = s; }
            const float p = exp2f(s - m); l += p;
#pragma unroll
            for (int d = 0; d < 64; ++d) acc[d] += p * bf2f(vp[d]);
        }
        const float il = 1.f / l;
        for (int d = 0; d < 64; ++d) CAT[(size_t)r * D + 512 + h * 64 + d] = f2bf(acc[d] * il);
    }
}

DEV int item_of(int d, int h, int pc) { return (d * 8 + h) * NPC + pc; }
DEV void phase_x1(Ctx& X) {
    const u16* PM = X.BIG; u16* QKC = X.XN;
    for (int it = X.gtid; it < R * 128; it += X.NT) {
        const int r = it / 128, c0 = (it % 128) * 8;
        const bool hp = (r != 0 && r != NCTX), hn = (r != NCTX - 1 && r != R - 1);
        const u16* p1 = PM + (size_t)r * PMW + c0;
        const bf16x8 z = (bf16x8){0, 0, 0, 0, 0, 0, 0, 0};
        const bf16x8 v1 = *(const bf16x8*)p1, v0 = hp ? *(const bf16x8*)(p1 - PMW) : z, v2 = hn ? *(const bf16x8*)(p1 + PMW) : z;
        const float sc = c0 < 512 ? 0.125f : 1.f; float y[8];
#pragma unroll
        for (int j = 0; j < 8; ++j) { const float a = X.ml_conv_w[c0 + j] * bf2f((u16)v0[j]) + X.ml_conv_w[1024 + c0 + j] * bf2f((u16)v1[j]) + X.ml_conv_w[2048 + c0 + j] * bf2f((u16)v2[j]); y[j] = silu_f(a) * sc; }
        u32x4 o; o.x = pk2(y[0], y[1]); o.y = pk2(y[2], y[3]); o.z = pk2(y[4], y[5]); o.w = pk2(y[6], y[7]);
        *(u32x4*)(QKC + (size_t)r * D + c0) = o;
    }
    for (int it = X.gw; it < NITEM; it += X.NGW) {
        const int d = it / (8 * NPC), h = (it / NPC) % 8, pc = it % NPC, lane = X.lane;
        const int pf = d == 0 ? 2 * lane : 2 * lane + 1, ps = d == 0 ? 2 * lane + 1 : 2 * lane;
        const float* g0 = X.G + (size_t)(pc * 128) * 32;
        const float lif = g0[pf * 32 + (2 * d) * 8 + h], lis = g0[ps * 32 + (2 * d) * 8 + h];
        const float lff = log_sigmoid_f(g0[pf * 32 + (2 * d + 1) * 8 + h]), lfs = log_sigmoid_f(g0[ps * 32 + (2 * d + 1) * 8 + h]);
        float P = lff + lfs;
#pragma unroll
        for (int o = 1; o < 64; o <<= 1) { const float t = d == 0 ? __shfl_up(P, o) : __shfl_down(P, o); const bool ok = d == 0 ? (lane >= o) : (lane + o < 64); if (ok) P += t; }
        const float total = __shfl(P, d == 0 ? 63 : 0);
        const float Cs = P, Cf = P - lfs;
        const float xf = lif - Cf, xs = lis - Cs;
        float M = fmaxf(xf, xs);
#pragma unroll
        for (int o = 1; o < 64; o <<= 1) { const float t = d == 0 ? __shfl_up(M, o) : __shfl_down(M, o); const bool ok = d == 0 ? (lane >= o) : (lane + o < 64); if (ok) M = fmaxf(M, t); }
        float ex = d == 0 ? __shfl_up(M, 1) : __shfl_down(M, 1); if (d == 0 ? lane == 0 : lane == 63) ex = -INFINITY;
        const float rmf = fmaxf(ex, xf), rms = fmaxf(rmf, xs);
        const float wf = total - Cf + lif, ws = total - Cs + lis;
        float mw = fmaxf(wf, ws);
#pragma unroll
        for (int o = 1; o < 64; o <<= 1) mw = fmaxf(mw, __shfl_xor(mw, o));
        float* bb = X.BB + (size_t)it * 128; float* li = X.LI + (size_t)it * 128; float* ee = X.EE + (size_t)it * 128; float* rm = X.RM + (size_t)it * 128;
        bb[pf] = Cf; bb[ps] = Cs; li[pf] = lif; li[ps] = lis; ee[pf] = __expf(wf - mw); ee[ps] = __expf(ws - mw); rm[pf] = rmf; rm[ps] = rms;
        if (lane == 0) { X.MLOC[it] = mw; X.BLAST[it] = total; }
    }
}
DEV void phase_m1_naive(Ctx& X) {
    const u16* PM = X.BIG; const u16* QKC = X.XN;
    for (long it = X.gtid; it < (long)NITEM * 8192; it += X.NT) {
        const int item = (int)(it / 8192), e = (int)(it % 8192), vv = e / 64, kk = e % 64, h = (item / NPC) % 8, pc = item % NPC;
        const float* ee = X.EE + (size_t)item * 128; float s = 0.f, sn = 0.f;
        for (int p = 0; p < 128; ++p) { const size_t row = (size_t)pc * 128 + p; const float kv = bf2f(QKC[row * D + 512 + h * 64 + kk]) * ee[p]; sn += kv; s += kv * bf2f(PM[row * PMW + 1024 + h * 128 + vv]); }
        X.CLOC[(size_t)item * 8192 + e] = s; if (vv == 0) X.NLOC[(size_t)item * 64 + kk] = sn;
    }
}
DEV int scan_pc(int d, int n) { return d == 0 ? n : (n == 0 ? 1 : (n == 1 ? 0 : 131 - n)); }
DEV void phase_m2(Ctx& X) {
    for (int it = X.gtid; it < 16 * 8192; it += X.NT) {
        const int dh = it >> 13, e = it & 8191; const bool hasn = e < 64;
        float* cb = X.CLOC + e; float* nb = X.NLOC + (hasn ? e : 0);
        float C = 0.f, Nn = 0.f, m = 0.f;
        float cl[13], nl[13], bl[13], ml[13]; int itm[13];
#define M2_LOAD(n0) _Pragma("unroll") for (int i = 0; i < 13; ++i) { itm[i] = dh * NPC + scan_pc(dh >> 3, (n0) + i); cl[i] = cb[(size_t)itm[i] * 8192]; nl[i] = hasn ? nb[(size_t)itm[i] * 64] : 0.f; bl[i] = X.BLAST[itm[i]]; ml[i] = X.MLOC[itm[i]]; }
        M2_LOAD(0)
#pragma unroll 1
        for (int n0 = 0; n0 < NPC; n0 += 13) {
            float ccl[13], cnl[13], cbl[13], cml[13]; int citm[13];
#pragma unroll
            for (int i = 0; i < 13; ++i) { ccl[i] = cl[i]; cnl[i] = nl[i]; cbl[i] = bl[i]; cml[i] = ml[i]; citm[i] = itm[i]; }
            if (n0 + 13 < NPC) { M2_LOAD(n0 + 13) }
#pragma unroll
            for (int i = 0; i < 13; ++i) {
                const float mn = fmaxf(cbl[i] + m, cml[i]), a = __expf(cbl[i] + m - mn), g = __expf(cml[i] - mn);
                cb[(size_t)citm[i] * 8192] = C; if (hasn) nb[(size_t)citm[i] * 64] = Nn; if (e == 0) X.MIN[citm[i]] = m;
                C = a * C + g * ccl[i]; Nn = a * Nn + g * cnl[i]; m = mn;
            }
        }
#undef M2_LOAD
    }
}
DEV void phase_m3_naive(Ctx& X) {
    u16* PM = X.BIG; const u16* QKC = X.XN;
    for (int it = X.gtid; it < 8 * 4 * NLAT; it += X.NT) {
        const int t = it % NLAT, hv = __builtin_amdgcn_readfirstlane(it / NLAT), h = hv / 4, vq = hv % 4, r = NCTX + t;
        const int pc = __builtin_amdgcn_readfirstlane(r / 128), j = r % 128;
        float q[64]; for (int k = 0; k < 64; ++k) q[k] = bf2f(QKC[(size_t)r * D + h * 64 + k]);
        float hacc[32]; for (int v = 0; v < 32; ++v) hacc[v] = 0.f;
        for (int d = 0; d < 2; ++d) {
            const int item = item_of(d, h, pc);
            const float* bb = X.BB + (size_t)item * 128; const float* li = X.LI + (size_t)item * 128;
            const float Bj = bb[j], m_in = X.MIN[item], mrow = Bj + fmaxf(m_in, X.RM[(size_t)item * 128 + j]), a = __expf(Bj + m_in - mrow);
            float num[32], den = 0.f;
            const float* cin = X.CLOC + (size_t)item * 8192 + (size_t)(vq * 32) * 64; const float* nin = X.NLOC + (size_t)item * 64;
            for (int k = 0; k < 64; ++k) den += nin[k] * q[k];
            den *= a;
            for (int v = 0; v < 32; ++v) { float s = 0.f; for (int k = 0; k < 64; ++k) s += cin[v * 64 + k] * q[k]; num[v] = a * s; }
            for (int s = 0; s < 128; ++s) {
                const bool valid = d == 0 ? (s <= j) : (s >= j);
                const size_t row = (size_t)pc * 128 + s; const u16* kp = QKC + row * D + 512 + h * 64; const u16* vp = PM + row * PMW + 1024 + h * 128 + vq * 32;
                float sc = 0.f;
#pragma unroll
                for (int k = 0; k < 64; ++k) sc += q[k] * bf2f(kp[k]);
                const float w = valid ? __expf(Bj - bb[s] + li[s] - mrow) : 0.f; sc *= w; den += sc;
#pragma unroll
                for (int v = 0; v < 32; ++v) num[v] += sc * bf2f(vp[v]);
            }
            const float inv = 1.f / fmaxf(fabsf(den), __expf(-mrow));
            for (int v = 0; v < 32; ++v) hacc[v] += num[v] * inv;
        }
        for (int v = 0; v < 32; ++v) PM[(size_t)r * PMW + h * 128 + vq * 32 + v] = f2bf(hacc[v]);
    }
}
DEV void phase_m3post(Ctx& X) {
    u16* PM = X.BIG;
    for (int it = X.gtid; it < 8 * NLAT; it += X.NT) {
        const int t = it % NLAT, h = it / NLAT; u16* p = PM + (size_t)(NCTX + t) * PMW + h * 128; const u16* o = p + 2048;
        float ss = 0.f; for (int v = 0; v < 128; ++v) { const float x = bf2f(p[v]); ss += x * x; }
        const float rs = rsqrtf(ss * (1.f / 128) + EPS);
        for (int v = 0; v < 128; ++v) p[v] = f2bf(bf2f(p[v]) * rs * X.ml_out_norm_g[h * 128 + v] * sigmoid_f(bf2f(o[v])));
    }
}

namespace pg8 {
#define PG8_LAS __attribute__((address_space(3)))
typedef unsigned short bf16_t;
typedef short bf16x8 __attribute__((ext_vector_type(8)));
typedef float f32x4 __attribute__((ext_vector_type(4)));
typedef unsigned u32x4 __attribute__((ext_vector_type(4)));
constexpr int BM = 256, BK = 64, HALF = 128, HTB = HALF * BK * 2  , STAGE_BYTES = 8 * HTB, NXCD = 8, WGM = 2;

__host__ __device__ __forceinline__ int lds_byte(int r, int c) { const int st = (r >> 4) * 2 + (c >> 5), rr = r & 15, cc = c & 31, ob = rr * 64 + cc * 2; return st * 1024 + (ob ^ (((ob >> 9) & 1) << 5)); }
__host__ __device__ __forceinline__ void stage_rc(int b, int& R, int& C) { const int st = b / 1024, sb = b % 1024, swz = sb ^ (((sb >> 9) & 1) << 5); R = (st >> 1) * 16 + swz / 64; C = (st & 1) * 32 + (swz % 64) / 2; }
__host__ __device__ __forceinline__ int perm32(int rho) { const int n = rho >> 4, i = rho & 15; return 8 * (i >> 2) + 4 * n + (i & 3); }

struct Unit { int pm, pn, ko; };
struct Gemm { const bf16_t* A; int lda; const bf16_t* Bt; int ldb; int M, N, K; };
struct Order {
    int nM, nN, nwg, G, c, pm0;
    __device__ void init(int M, int N, int G_, int c_, int pm0_) { nM = M / BM; nN = N / BM; nwg = nM * nN; G = G_; c = c_; pm0 = pm0_; }
    __device__ bool next(int i, Unit& u) const {
        const long L = (long)i * G + c; if (L >= nwg) return false;
        int wgid = (int)L; { const int q = nwg / NXCD, r = nwg % NXCD, xcd = wgid % NXCD, off = wgid / NXCD; wgid = (xcd < r ? xcd * (q + 1) : r * (q + 1) + (xcd - r) * q) + off; }
        const int nig = WGM * nN, gid = wgid / nig, fm = gid * WGM, gsz = (nM - fm) < WGM ? (nM - fm) : WGM;
        u.pm = pm0 + fm + ((wgid % nig) % gsz); u.pn = (wgid % nig) / gsz; u.ko = 0; return true;
    }
    __device__ __forceinline__ void a_ready(const Unit&) const {}
    __device__ __forceinline__ void done(const Unit&) const {}
};
struct OrderKS {
    int nN, nwg, G, c, kc;
    __device__ void init(int N, int S, int kc_, int G_, int c_) { nN = N / BM; nwg = nN * S; G = G_; c = c_; kc = kc_; }
    __device__ bool next(int i, Unit& u) const { const long L = (long)i * G + c; if (L >= nwg) return false; u.pm = 0; u.pn = (int)L % nN; u.ko = ((int)L / nN) * kc; return true; }
    __device__ __forceinline__ void a_ready(const Unit&) const {}
    __device__ __forceinline__ void done(const Unit&) const {}
};

template <class Epi, class Sched, bool ALIGN_EPI = false, bool SP2 = false>
__device__ __forceinline__ void gemm_phase(PG8_LAS unsigned char* lds, const Gemm g, const Sched& S, const Epi& E) {
    const int tid = tid_fresh(), wid = __builtin_amdgcn_readfirstlane(tid >> 6), lane = tid & 63, wr = wid >> 2, wc = wid & 3, fr = lane & 15, fq = lane >> 4;
    const int K = g.K, nt = K / BK;
    unsigned voffA[2], voffB[2];
#pragma unroll
    for (int i = 0; i < 2; ++i) { int R, C; stage_rc(tid * 16 + i * 8192, R, C); const int Rb = Epi::PERM ? ((R & ~31) + perm32(R & 31)) : R;
        voffA[i] = (unsigned)(R * g.lda + C) * 2u; voffB[i] = (unsigned)(Rb * g.ldb + C) * 2u; }
    const size_t kstep = (size_t)(BK * 2);
    const size_t hstepA = (size_t)HALF * g.lda * 2, hstepB = (size_t)HALF * g.ldb * 2;
    const size_t tstepA = 2 * hstepA, tstepB = 2 * hstepB;
    const unsigned ldsw = (unsigned)wid * 1024u;
    const int aoff = lds_byte(wr * 64 + fr, fq * 8), boff = lds_byte(wc * 32 + fr, fq * 8);
#define PG8_SA(b, h) (((b) * 2 + (h)) * HTB)
#define PG8_SB(b, h) ((4 + (b) * 2 + (h)) * HTB)
#define PG8_STAGE(bufoff, gbase, voff) do { _Pragma("unroll") for (int _i = 0; _i < 2; ++_i) \
        __builtin_amdgcn_global_load_lds((const unsigned*)((const char*)(gbase) + (voff)[_i]), (PG8_LAS unsigned*)(lds + (bufoff) + ldsw + _i * 8192), 16, 0, 0); } while (0)
#define PG8_LDA(dst, b, h) do { _Pragma("unroll") for (int m = 0; m < 4; ++m) _Pragma("unroll") for (int k = 0; k < 2; ++k) dst[m][k] = *(const PG8_LAS bf16x8*)(lds + PG8_SA(b, h) + aoff + m * 2048 + k * 1024); } while (0)
#define PG8_LDB(dst, b, h) do { _Pragma("unroll") for (int n = 0; n < 2; ++n) _Pragma("unroll") for (int k = 0; k < 2; ++k) dst[n][k] = *(const PG8_LAS bf16x8*)(lds + PG8_SB(b, h) + boff + n * 2048 + k * 1024); } while (0)
#define PG8_MMA(ai, bj, At, Bt) do { __builtin_amdgcn_s_setprio(1); _Pragma("unroll") for (int m = 0; m < 4; ++m) _Pragma("unroll") for (int n = 0; n < 2; ++n) _Pragma("unroll") for (int k = 0; k < 2; ++k) \
        acc[ai][bj][m][n] = __builtin_amdgcn_mfma_f32_16x16x32_bf16(Bt[n][k], At[m][k], acc[ai][bj][m][n], 0, 0, 0); __builtin_amdgcn_s_setprio(0); } while (0)
#define PG8_WAIT_V(n) asm volatile("s_waitcnt vmcnt(" #n ")" ::: "memory")
#define PG8_WAIT_L(n) asm volatile("s_waitcnt lgkmcnt(" #n ")" ::: "memory")
#define PG8_BAR __builtin_amdgcn_s_barrier()
#define PG8_SCHED __builtin_amdgcn_sched_barrier(0)
    Unit cur, nxt; int ui = 0;
    if (!S.next(0, cur)) return;
    f32x4 acc[2][2][4][2];
#pragma unroll
    for (int a = 0; a < 2; ++a)
#pragma unroll
        for (int b = 0; b < 2; ++b)
#pragma unroll
            for (int m = 0; m < 4; ++m)
#pragma unroll
                for (int n = 0; n < 2; ++n) acc[a][b][m][n] = (f32x4){0.f, 0.f, 0.f, 0.f};
    bf16x8 At[4][2], B0[2][2], B1[2][2];
    const char* cA = (const char*)g.A + (size_t)cur.pm * tstepA + (size_t)cur.ko * 2; const char* cB = (const char*)g.Bt + (size_t)cur.pn * tstepB + (size_t)cur.ko * 2;
    S.a_ready(cur);
    if constexpr (SP2) {
        PG8_STAGE(PG8_SB(0, 0), cB, voffB); PG8_STAGE(PG8_SB(0, 1), cB + hstepB, voffB); PG8_STAGE(PG8_SA(0, 0), cA, voffA); PG8_STAGE(PG8_SA(0, 1), cA + hstepA, voffA);
        if (wr == 1) PG8_BAR;
        PG8_WAIT_V(2); PG8_BAR;
        PG8_STAGE(PG8_SB(1, 0), cB + kstep, voffB); PG8_STAGE(PG8_SA(1, 0), cA + kstep, voffA); PG8_STAGE(PG8_SB(1, 1), cB + hstepB + kstep, voffB);
        PG8_WAIT_V(6); PG8_BAR;
    } else {
        PG8_STAGE(PG8_SB(0, 0), cB, voffB); PG8_STAGE(PG8_SA(0, 0), cA, voffA); PG8_STAGE(PG8_SB(0, 1), cB + hstepB, voffB); PG8_STAGE(PG8_SA(0, 1), cA + hstepA, voffA);
        if (wr == 1) PG8_BAR;
        PG8_WAIT_V(4); PG8_BAR;
        PG8_STAGE(PG8_SB(1, 0), cB + kstep, voffB); PG8_STAGE(PG8_SA(1, 0), cA + kstep, voffA); PG8_STAGE(PG8_SB(1, 1), cB + hstepB + kstep, voffB);
        PG8_WAIT_V(6); PG8_BAR;
    }
    for (;;) {
        const bool has_next = S.next(ui + 1, nxt);
        const char* nA = has_next ? (const char*)g.A + (size_t)nxt.pm * tstepA + (size_t)nxt.ko * 2 : cA; const char* nB = has_next ? (const char*)g.Bt + (size_t)nxt.pn * tstepB + (size_t)nxt.ko * 2 : cB;
        for (int t = 0; t < nt; t += 2) {
            const bool last = (t == nt - 2);
            const char* a1 = cA + (size_t)(t + 1) * kstep;
            const char* a2 = last ? nA : cA + (size_t)(t + 2) * kstep; const char* b2 = last ? nB : cB + (size_t)(t + 2) * kstep;
            const char* a3 = a2 + kstep; const char* b3 = b2 + kstep;
            if (last && has_next) S.a_ready(nxt);
            if constexpr (SP2) {
            PG8_LDB(B0, 0, 0); PG8_LDB(B1, 0, 1); PG8_SCHED; PG8_LDA(At, 0, 0); PG8_STAGE(PG8_SA(1, 1), a1 + hstepA, voffA);
            PG8_WAIT_V(8); PG8_WAIT_L(0); PG8_BAR; PG8_MMA(0, 0, At, B0); PG8_MMA(0, 1, At, B1); PG8_BAR; PG8_SCHED;
            PG8_LDA(At, 0, 1); PG8_STAGE(PG8_SB(0, 0), b2, voffB); PG8_STAGE(PG8_SB(0, 1), b2 + hstepB, voffB); PG8_STAGE(PG8_SA(0, 0), a2, voffA);
            PG8_WAIT_V(8); PG8_WAIT_L(0); PG8_BAR; PG8_MMA(1, 0, At, B0); PG8_MMA(1, 1, At, B1); PG8_BAR; PG8_SCHED;
            PG8_LDB(B0, 1, 0); PG8_LDB(B1, 1, 1); PG8_SCHED; PG8_LDA(At, 1, 0); PG8_STAGE(PG8_SA(0, 1), a2 + hstepA, voffA);
            PG8_WAIT_V(8); PG8_WAIT_L(0); PG8_BAR; PG8_MMA(0, 0, At, B0); PG8_MMA(0, 1, At, B1); PG8_BAR; PG8_SCHED;
            PG8_LDA(At, 1, 1); PG8_STAGE(PG8_SB(1, 0), b3, voffB); PG8_STAGE(PG8_SB(1, 1), b3 + hstepB, voffB); PG8_STAGE(PG8_SA(1, 0), a3, voffA);
            PG8_WAIT_V(8); PG8_WAIT_L(0); PG8_BAR; PG8_MMA(1, 0, At, B0); PG8_MMA(1, 1, At, B1); PG8_BAR; PG8_SCHED;
            } else {
            PG8_LDB(B0, 0, 0); PG8_SCHED; PG8_LDA(At, 0, 0); PG8_STAGE(PG8_SA(1, 1), a1 + hstepA, voffA);
            PG8_WAIT_L(8); PG8_BAR; PG8_WAIT_L(0); PG8_MMA(0, 0, At, B0); PG8_BAR; PG8_SCHED;
            PG8_LDB(B1, 0, 1); PG8_STAGE(PG8_SB(0, 0), b2, voffB);
            PG8_BAR; PG8_WAIT_L(0); PG8_MMA(0, 1, At, B1); PG8_BAR;
            PG8_LDA(At, 0, 1); PG8_STAGE(PG8_SA(0, 0), a2, voffA);
            PG8_BAR; PG8_WAIT_L(0); PG8_MMA(1, 0, At, B0); PG8_BAR; PG8_SCHED;
            PG8_STAGE(PG8_SB(0, 1), b2 + hstepB, voffB);
            PG8_WAIT_V(6); PG8_BAR; PG8_MMA(1, 1, At, B1); PG8_BAR;
            PG8_LDB(B0, 1, 0); PG8_SCHED; PG8_LDA(At, 1, 0); PG8_STAGE(PG8_SA(0, 1), a2 + hstepA, voffA);
            PG8_WAIT_L(8); PG8_BAR; PG8_WAIT_L(0); PG8_MMA(0, 0, At, B0); PG8_BAR; PG8_SCHED;
            PG8_LDB(B1, 1, 1); PG8_STAGE(PG8_SB(1, 0), b3, voffB);
            PG8_BAR; PG8_WAIT_L(0); PG8_MMA(0, 1, At, B1); PG8_BAR;
            PG8_LDA(At, 1, 1); PG8_STAGE(PG8_SA(1, 0), a3, voffA);
            PG8_BAR; PG8_WAIT_L(0); PG8_MMA(1, 0, At, B0); PG8_BAR; PG8_SCHED;
            PG8_STAGE(PG8_SB(1, 1), b3 + hstepB, voffB);
            PG8_WAIT_V(6); PG8_BAR; PG8_MMA(1, 1, At, B1); PG8_BAR;
            }
        }
        if constexpr (ALIGN_EPI) { if (wr == 0) PG8_BAR; }
        if constexpr (!Epi::AFTER_DRAIN) { E(acc, cur, wr, wc, fr, fq); S.done(cur); }
        if (!has_next) break;
#pragma unroll
        for (int a = 0; a < 2; ++a)
#pragma unroll
            for (int b = 0; b < 2; ++b)
#pragma unroll
                for (int m = 0; m < 4; ++m)
#pragma unroll
                    for (int n = 0; n < 2; ++n) acc[a][b][m][n] = (f32x4){0.f, 0.f, 0.f, 0.f};
        cur = nxt; cA = nA; cB = nB; ++ui;
        if constexpr (ALIGN_EPI) { if (wr == 1) PG8_BAR; }
    }
    PG8_WAIT_V(0);
    if constexpr (!ALIGN_EPI) { if (wr == 0) PG8_BAR; }
    PG8_BAR;
    if constexpr (Epi::AFTER_DRAIN) { E.fused(acc, cur, wr, wc, fr, fq, lds, wid, lane); S.done(cur); }
#undef PG8_SA
#undef PG8_SB
#undef PG8_STAGE
#undef PG8_LDA
#undef PG8_LDB
#undef PG8_MMA
#undef PG8_WAIT_V
#undef PG8_WAIT_L
#undef PG8_BAR
#undef PG8_SCHED
}
}


DEV float fast_silu(float g) { return g * __builtin_amdgcn_rcpf(1.f + __expf(-g)); }
DEV float fast_gelu(float x) { const float u = 0.7978845608028654f * (x + 0.044715f * x * x * x); const float e = __expf(2.f * u); return x * (1.f - __builtin_amdgcn_rcpf(e + 1.f)); }
typedef pg8::f32x4 pf4;
struct EpiSwiGLU { static constexpr bool PERM = true, AFTER_DRAIN = false; u16* HID;
    DEV void operator()(const pf4 (&acc)[2][2][4][2], const pg8::Unit& u, int wr, int wc, int fr_, int fq_) const {
        int fr = fr_, fq = fq_; asm volatile("" : "+v"(fr), "+v"(fq));
        const int row0 = u.pm * 256 + wr * 64 + fr, col0 = u.pn * 128 + wc * 32 + 8 * fq;
#pragma unroll
        for (int ai = 0; ai < 2; ++ai)
#pragma unroll
            for (int m = 0; m < 4; ++m) {
                const pf4 g0 = acc[ai][0][m][0], g1 = acc[ai][0][m][1], u0 = acc[ai][1][m][0], u1 = acc[ai][1][m][1];
                u32x4 w; w.x = pk2(fast_silu(g0[0]) * u0[0], fast_silu(g0[1]) * u0[1]); w.y = pk2(fast_silu(g0[2]) * u0[2], fast_silu(g0[3]) * u0[3]);
                w.z = pk2(fast_silu(g1[0]) * u1[0], fast_silu(g1[1]) * u1[1]); w.w = pk2(fast_silu(g1[2]) * u1[2], fast_silu(g1[3]) * u1[3]);
                *(u32x4*)(HID + (size_t)(row0 + ai * 128 + m * 16) * FH + col0) = w;
            }
    } };
struct EpiResid { static constexpr bool PERM = false, AFTER_DRAIN = false; const float* bctx; const float* blat; float* H; const float* mvl; const float* mvc; float mul;
    DEV void operator()(const pf4 (&acc)[2][2][4][2], const pg8::Unit& u, int wr, int wc, int fr_, int fq_) const {
        int fr = fr_, fq = fq_; asm volatile("" : "+v"(fr), "+v"(fq));
        const int row0 = u.pm * 256 + wr * 64 + fr, col0 = u.pn * 256 + wc * 32 + 4 * fq;
        const float* mv = u.pm == 0 ? mvc : mvl;
        pf4 mm[2][2];
#pragma unroll
        for (int bj = 0; bj < 2; ++bj)
#pragma unroll
            for (int n = 0; n < 2; ++n) mm[bj][n] = *(const pf4*)(mv + col0 + bj * 128 + n * 16) * mul;
#pragma unroll
        for (int ai = 0; ai < 2; ++ai)
#pragma unroll
            for (int m = 0; m < 4; ++m) {
                const int r = row0 + ai * 128 + m * 16;
                const float* bp = (r < NCTX ? bctx + (size_t)r * D : blat + (size_t)(r - NCTX) * D) + col0; float* hp = H + (size_t)r * D + col0;
#pragma unroll
                for (int bj = 0; bj < 2; ++bj)
#pragma unroll
                    for (int n = 0; n < 2; ++n) { const pf4 b = *(const pf4*)(bp + bj * 128 + n * 16); *(pf4*)(hp + bj * 128 + n * 16) = b + mm[bj][n] * acc[ai][bj][m][n]; }
            }
    } };
template <int mode, int SITE, int MVOFF, int SHOFF, int NGOFF, bool FROM_IN, int MUL2> struct EpiResidNorm { static constexpr bool PERM = false, AFTER_DRAIN = true;
    unsigned char* wsb; const float* ngbase; const float* xin; float* out;
    DEV void fused(pf4 (&acc)[2][2][4][2], const pg8::Unit& u, int wr, int wc, int fr_, int fq_, PG8_LAS unsigned char* lds, int wid, int lane) const {
        int fr = fr_, fq = fq_; asm volatile("" : "+v"(fr), "+v"(fq));
        PG8_LAS float* P = (PG8_LAS float*)lds; PG8_LAS float* S = (PG8_LAS float*)(lds + 8192);
        float* H = (float*)(wsb + WS_H); const float* blat = FROM_IN ? xin : H + (size_t)NCTX * D; const float* mvl = (const float*)(wsb + WS_MV) + MVOFF; const float* shv = (const float*)(wsb + WS_MV) + SHOFF;
        const float* ng = ngbase + NGOFF; u16* XN = (u16*)(wsb + WS_XN); unsigned long long* rss = (unsigned long long*)(wsb + WS_RSS) + (size_t)SITE * R; unsigned* cnt = (unsigned*)(wsb + WS_BAR + 16 * KiB) + SITE * 65 * 16; const float mul = 0.5f * MUL2;
        const int rl0 = wr * 64 + fr, col0 = u.pn * 256 + wc * 32 + 4 * fq;
        {
            pf4 mm[2][2];
#pragma unroll
            for (int bj = 0; bj < 2; ++bj)
#pragma unroll
                for (int n = 0; n < 2; ++n) mm[bj][n] = *(const pf4*)(mvl + col0 + bj * 128 + n * 16) * mul;
#pragma unroll
            for (int ai = 0; ai < 2; ++ai)
#pragma unroll
                for (int m = 0; m < 4; ++m) {
                    const int rl = rl0 + ai * 128 + m * 16; const size_t r = (size_t)u.pm * 256 + rl;
                    const float* bp = blat + (r - NCTX) * D + col0; float* hp = H + r * D + col0; float ss = 0.f;
#pragma unroll
                    for (int bj = 0; bj < 2; ++bj)
#pragma unroll
                        for (int n = 0; n < 2; ++n) { const pf4 hv = *(const pf4*)(bp + bj * 128 + n * 16) + mm[bj][n] * acc[ai][bj][m][n]; acc[ai][bj][m][n] = hv;
                            ss += (hv[0] * hv[0] + hv[1] * hv[1]) + (hv[2] * hv[2] + hv[3] * hv[3]); if (mode == 0) *(pf4*)(hp + bj * 128 + n * 16) = hv; }
                    ss += __shfl_xor(ss, 16); ss += __shfl_xor(ss, 32);
                    if (fq == 0) P[rl * 4 + wc] = ss;
                    asm volatile("" ::: "memory");
                }
        }
        asm volatile("s_waitcnt lgkmcnt(0)" ::: "memory"); __builtin_amdgcn_s_barrier(); asm volatile("" ::: "memory");
        const int row = wid * 32 + (lane & 31);
        if (lane < 32) { const float t = (P[row * 4 + 0] + P[row * 4 + 1]) + (P[row * 4 + 2] + P[row * 4 + 3]);
            __hip_atomic_fetch_add(rss + (size_t)u.pm * 256 + row, (unsigned long long)(t * 16777216.f), __ATOMIC_RELAXED, __HIP_MEMORY_SCOPE_AGENT); }
        asm volatile("s_waitcnt vmcnt(0)" ::: "memory");
        if (lane == 0) __hip_atomic_fetch_add(cnt + 16 * u.pm, 1u, __ATOMIC_RELAXED, __HIP_MEMORY_SCOPE_AGENT);
        if (wid == 0) {
            unsigned sp = 0;
            while ((unsigned)__builtin_amdgcn_readfirstlane(__hip_atomic_load(cnt + 16 * u.pm, __ATOMIC_RELAXED, __HIP_MEMORY_SCOPE_AGENT)) < 32u) { __builtin_amdgcn_s_sleep(2); if (++sp > (1u << 22)) break; }
            __builtin_amdgcn_fence(__ATOMIC_ACQUIRE, "agent");
        }
        asm volatile("s_waitcnt vmcnt(0) lgkmcnt(0)" ::: "memory"); __builtin_amdgcn_s_barrier(); asm volatile("" ::: "memory");
        if (lane < 32) { const unsigned long long a = __hip_atomic_fetch_add(rss + (size_t)u.pm * 256 + row, 0ull, __ATOMIC_RELAXED, __HIP_MEMORY_SCOPE_AGENT);
            const float t = (float)a * (1.f / 16777216.f);
            S[row] = rsqrtf(t * (1.f / D) + EPS); }
        asm volatile("s_waitcnt lgkmcnt(0)" ::: "memory"); __builtin_amdgcn_s_barrier(); asm volatile("" ::: "memory");
#pragma unroll
        for (int bj = 0; bj < 2; ++bj)
#pragma unroll
            for (int n = 0; n < 2; ++n) {
                const int c = col0 + bj * 128 + n * 16;
                pf4 gm = *(const pf4*)(ng + c), sh = (pf4){0.f, 0.f, 0.f, 0.f};
                if (mode == 0) { gm = gm * (*(const pf4*)(shv + D + c) + 1.f); sh = *(const pf4*)(shv + c); }
#pragma unroll
                for (int ai = 0; ai < 2; ++ai)
#pragma unroll
                    for (int m = 0; m < 4; ++m) {
                        const int rl = rl0 + ai * 128 + m * 16; const size_t r = (size_t)u.pm * 256 + rl; const float rs = S[rl];
                        const pf4 y = acc[ai][bj][m][n] * rs * gm + sh;
                        if (mode == 0) { u32x2 w; w.x = pk2(y[0], y[1]); w.y = pk2(y[2], y[3]); *(u32x2*)(XN + r * D + c) = w; }
                        else *(pf4*)(out + (r - NCTX) * D + c) = y;
                    }
                asm volatile("" ::: "memory");
            }
        asm volatile("s_waitcnt lgkmcnt(0)" ::: "memory"); __builtin_amdgcn_s_barrier(); asm volatile("" ::: "memory");
    } };
struct EpiPartial { static constexpr bool PERM = false, AFTER_DRAIN = false; float* P; const float* mv; float mul; int kc;
    DEV void operator()(const pf4 (&acc)[2][2][4][2], const pg8::Unit& u, int wr, int wc, int fr_, int fq_) const {
        int fr = fr_, fq = fq_; asm volatile("" : "+v"(fr), "+v"(fq));
        const int row0 = (u.ko / kc) * 256 + wr * 64 + fr, col0 = u.pn * 256 + wc * 32 + 4 * fq;
#pragma unroll
        for (int ai = 0; ai < 2; ++ai)
#pragma unroll
            for (int m = 0; m < 4; ++m) {
                float* pp = P + (size_t)(row0 + ai * 128 + m * 16) * D + col0;
#pragma unroll
                for (int bj = 0; bj < 2; ++bj)
#pragma unroll
                    for (int n = 0; n < 2; ++n) *(pf4*)(pp + bj * 128 + n * 16) = *(const pf4*)(mv + col0 + bj * 128 + n * 16) * mul * acc[ai][bj][m][n];
                asm volatile("" ::: "memory");
            }
    } };
struct EpiML { static constexpr bool PERM = true, AFTER_DRAIN = false; u16* PM; float* G; const float* gb;
    DEV void operator()(const pf4 (&acc)[2][2][4][2], const pg8::Unit& u, int wr, int wc, int fr_, int fq_) const {
        int fr = fr_, fq = fq_; asm volatile("" : "+v"(fr), "+v"(fq));
        const int row0 = u.pm * 256 + wr * 64 + fr;
        if (u.pn < 12) {
            const int col0 = u.pn * 256 + wc * 32 + 8 * fq;
#pragma unroll
            for (int ai = 0; ai < 2; ++ai)
#pragma unroll
                for (int m = 0; m < 4; ++m)
#pragma unroll
                    for (int bj = 0; bj < 2; ++bj) { const pf4 a = acc[ai][bj][m][0], b = acc[ai][bj][m][1];
                        u32x4 w; w.x = pk2(a[0], a[1]); w.y = pk2(a[2], a[3]); w.z = pk2(b[0], b[1]); w.w = pk2(b[2], b[3]);
                        *(u32x4*)(PM + (size_t)(row0 + ai * 128 + m * 16) * PMW + col0 + bj * 128) = w; }
        } else if (wc == 0) {
            const pf4 b0 = *(const pf4*)(gb + 8 * fq), b1 = *(const pf4*)(gb + 8 * fq + 4);
#pragma unroll
            for (int ai = 0; ai < 2; ++ai)
#pragma unroll
                for (int m = 0; m < 4; ++m) { float* gp = G + (size_t)(row0 + ai * 128 + m * 16) * 32 + 8 * fq; *(pf4*)gp = acc[ai][0][m][0] + b0; *(pf4*)(gp + 4) = acc[ai][0][m][1] + b1; }
        }
    } };
struct EpiAB { static constexpr bool PERM = false, AFTER_DRAIN = false; u16* P0; const float* gng; const float* qg; const float* kg; const float* rt;
    static DEV void store16(u16* dp, const pf4 (&v)[2][2]) {
#pragma unroll
        for (int bj = 0; bj < 2; ++bj)
#pragma unroll
            for (int n = 0; n < 2; ++n) { u32x2 w; w.x = pk2(v[bj][n][0], v[bj][n][1]); w.y = pk2(v[bj][n][2], v[bj][n][3]); *(u32x2*)(dp + 32 * bj + 16 * n) = w; }
    }
    DEV void operator()(const pf4 (&acc)[2][2][4][2], const pg8::Unit& u, int wr, int wc, int fr_, int fq_) const {
        int fr = fr_, fq = fq_; asm volatile("" : "+v"(fr), "+v"(fq));
        const int row0 = u.pm * 256 + wr * 64 + fr, colw = u.pn * 256 + wc * 64 + 4 * fq;
        const int kind = u.pn < 2 ? 0 : (u.pn < 4 ? 1 : (u.pn < 6 ? 2 : (wc < 2 ? 3 : 4)));
        if (kind == 0 || kind == 4) {
#pragma unroll
            for (int ai = 0; ai < 2; ++ai)
#pragma unroll
                for (int m = 0; m < 4; ++m) {
                    pf4 v[2][2];
#pragma unroll
                    for (int bj = 0; bj < 2; ++bj)
#pragma unroll
                        for (int n = 0; n < 2; ++n)
#pragma unroll
                            for (int j = 0; j < 4; ++j) v[bj][n][j] = kind == 0 ? fast_gelu(acc[ai][bj][m][n][j]) : acc[ai][bj][m][n][j];
                    store16(P0 + (size_t)(row0 + ai * 128 + m * 16) * EVEN_IN + colw, v);
                    asm volatile("" ::: "memory");
                }
            return;
        }
        const float* gp = kind == 1 ? gng + (colw - 512) : (kind == 2 ? qg : kg) + 4 * fq;
        const bool rope = kind >= 2 && u.pm > 0;
        const float osc = kind == 2 ? C2 : 1.f;
#pragma unroll
        for (int ai = 0; ai < 2; ++ai)
#pragma unroll
            for (int m = 0; m < 4; ++m) {
                const int r = row0 + ai * 128 + m * 16;
                pf4 v[2][2]; float ss = 0.f;
#pragma unroll
                for (int bj = 0; bj < 2; ++bj)
#pragma unroll
                    for (int n = 0; n < 2; ++n)
#pragma unroll
                        for (int j = 0; j < 4; ++j) { const float a = acc[ai][bj][m][n][j]; const float x = kind == 1 ? fast_gelu(a) : a; v[bj][n][j] = x; ss += x * x; }
                ss += __shfl_xor(ss, 16); ss += __shfl_xor(ss, 32);
                const float rs = rsqrtf(ss * (1.f / 64) + EPS) * osc;
#pragma unroll
                for (int bj = 0; bj < 2; ++bj)
#pragma unroll
                    for (int n = 0; n < 2; ++n) v[bj][n] = v[bj][n] * rs * *(const pf4*)(gp + 32 * bj + 16 * n);
                if (rope) {
                    const int t = r - NCTX;
#pragma unroll
                    for (int bj = 0; bj < 2; ++bj) {
                        const float* tp = rt + (bj == 0 ? (t >> 6) : (t & 63)) * 32 + 4 * fq;
                        const pf4 cs = *(const pf4*)tp, sn = *(const pf4*)(tp + 16);
                        const pf4 x1 = v[bj][0], x2 = v[bj][1]; v[bj][0] = x1 * cs - x2 * sn; v[bj][1] = x2 * cs + x1 * sn;
                    }
                }
                store16(P0 + (size_t)r * EVEN_IN + colw, v);
                asm volatile("" ::: "memory");
            }
    } };

#include <hip/hip_bf16.h>
namespace attn_body {
using bf16=__hip_bfloat16;
using bf16x8=__attribute__((ext_vector_type(8)))short;
using s16x4=__attribute__((ext_vector_type(4)))short;
using f32x16=__attribute__((ext_vector_type(16)))float;
using u32x4=__attribute__((ext_vector_type(4)))unsigned;
constexpr int D=64,PQ=1792,PO=1024;
constexpr int NW=8,QBLK=32,QB=QBLK*NW,KVBLK=64;
__device__ __forceinline__ int crow(int r,int hi){return (r&3)+8*(r>>2)+4*hi;}
#define SBAR() __builtin_amdgcn_sched_barrier(0)
__device__ __forceinline__ void cmask(f32x16&p0,f32x16&p1,int jb,int qrel,int hi){
  const float NEG=-INFINITY; int kb=64*jb+4*hi;
  #pragma unroll
  for(int r=0;r<16;++r){int kv=kb+(r&3)+8*(r>>2); if(kv>qrel)p0[r]=NEG; if(kv+32>qrel)p1[r]=NEG;}
}

constexpr int NSLOT=3, SLOTB=8192;
constexpr int LDS_K=0, LDS_V=NSLOT*SLOTB, LDS_WS=2*NSLOT*SLOTB, LDS_OST=LDS_WS+NW*64*4, LDS_BYTES=LDS_OST+NW*4096;
constexpr float C2=0.125f*1.4426950408889634f;
__device__ __forceinline__ void glds16(const void*gsrc,unsigned lds_dst){unsigned keep;
  asm volatile("s_mov_b32 %0, m0\n\ts_mov_b32 m0, %2\n\ts_nop 0\n\tglobal_load_lds_dwordx4 %1, off\n\ts_mov_b32 m0, %0":"=&s"(keep):"v"(gsrc),"s"(lds_dst):"memory");}
__device__ __forceinline__ float max3f(float a,float b,float c){float r;asm("v_max3_f32 %0, %1, %2, %3":"=v"(r):"v"(a),"v"(b),"v"(c));return r;}
__device__ __forceinline__ float max2f(float a,float b){float r;asm("v_max_f32_e32 %0, %1, %2":"=v"(r):"v"(a),"v"(b));return r;}
__device__ __forceinline__ float fadd_s(float a,float b){float r;asm("v_add_f32_e32 %0, %1, %2":"=v"(r):"v"(a),"v"(b));return r;}
__device__ __forceinline__ float fsub_s(float a,float b){float r;asm("v_sub_f32_e32 %0, %1, %2":"=v"(r):"v"(a),"v"(b));return r;}
typedef float f32x2_t __attribute__((ext_vector_type(2))); typedef __bf16 bf16x2_t __attribute__((ext_vector_type(2)));
__device__ __forceinline__ unsigned cvtpk_s(float lo,float hi){f32x2_t v={lo,hi};bf16x2_t b=__builtin_convertvector(v,bf16x2_t);return __builtin_bit_cast(unsigned,b);}
#define WAIT_BAR(N) asm volatile("s_waitcnt vmcnt(" #N ") lgkmcnt(0)\n\ts_barrier":::"memory")

__device__ __forceinline__ void qkt(f32x16&p0,f32x16&p1,const char*Kslot,const bf16x8*qr,const f32x16&negm,int r32,int hi){
  const char*kb=Kslot+hi*1024+r32*16;
  #pragma unroll
  for(int d0=0;d0<4;++d0){
    const bf16x8 b0=*reinterpret_cast<const bf16x8*>(kb+d0*2048);
    const bf16x8 b1=*reinterpret_cast<const bf16x8*>(kb+d0*2048+512);
    if(d0==0){p0=__builtin_amdgcn_mfma_f32_32x32x16_bf16(b0,qr[0],negm,0,0,0);p1=__builtin_amdgcn_mfma_f32_32x32x16_bf16(b1,qr[0],negm,0,0,0);}
    else{p0=__builtin_amdgcn_mfma_f32_32x32x16_bf16(b0,qr[d0],p0,0,0,0);p1=__builtin_amdgcn_mfma_f32_32x32x16_bf16(b1,qr[d0],p1,0,0,0);}}
}
typedef __attribute__((address_space(3))) const char* lds_cptr;
typedef short v4i16_t __attribute__((ext_vector_type(4)));
__device__ __forceinline__ void kload8(bf16x8*kf,lds_cptr kp){
  kf[0]=*(const __attribute__((address_space(3))) bf16x8*)(kp);      kf[1]=*(const __attribute__((address_space(3))) bf16x8*)(kp+512);
  kf[2]=*(const __attribute__((address_space(3))) bf16x8*)(kp+2048); kf[3]=*(const __attribute__((address_space(3))) bf16x8*)(kp+2560);
  kf[4]=*(const __attribute__((address_space(3))) bf16x8*)(kp+4096); kf[5]=*(const __attribute__((address_space(3))) bf16x8*)(kp+4608);
  kf[6]=*(const __attribute__((address_space(3))) bf16x8*)(kp+6144); kf[7]=*(const __attribute__((address_space(3))) bf16x8*)(kp+6656);
}
__device__ __forceinline__ void kload2(bf16x8*kf,lds_cptr kp,int j){ kf[2*j]=*(const __attribute__((address_space(3))) bf16x8*)(kp+j*2048); kf[2*j+1]=*(const __attribute__((address_space(3))) bf16x8*)(kp+j*2048+512); }
__device__ __forceinline__ s16x4 vtr(lds_cptr p){ return __builtin_bit_cast(s16x4,__builtin_amdgcn_ds_read_tr16_b64_v4i16((__attribute__((address_space(3))) v4i16_t*)p)); }
__device__ __forceinline__ float rowmax(const f32x16&p0,const f32x16&p1){
  float a=max3f(p0[0],p0[1],p1[0]),b=max3f(p0[2],p0[3],p1[1]);a=max3f(a,p1[2],p1[3]);
  #pragma unroll
  for(int r=4;r<16;r+=4){a=max3f(a,p0[r],p0[r+1]);b=max3f(b,p0[r+2],p0[r+3]);a=max3f(a,p1[r],p1[r+1]);b=max3f(b,p1[r+2],p1[r+3]);}
  const float m=max2f(a,b);
  auto rr=__builtin_amdgcn_permlane32_swap(__float_as_uint(m),__float_as_uint(m),false,false);
  return max2f(__uint_as_float(rr[0]),__uint_as_float(rr[1]));
}
__device__ __forceinline__ void pv(f32x16*o,int vb,bf16x8 pa0,bf16x8 pa1,bf16x8 pa2,bf16x8 pa3){
  #pragma unroll
  for(int d0=0;d0<2;++d0){s16x4 lo[4],hi[4];
    #pragma unroll
    for(int ks=0;ks<4;++ks){
      asm volatile("ds_read_b64_tr_b16 %0,%1 offset:%c2":"=&v"(lo[ks]):"v"(vb),"i"(d0*4096+ks*1024):"memory");
      asm volatile("ds_read_b64_tr_b16 %0,%1 offset:%c2":"=&v"(hi[ks]):"v"(vb),"i"(d0*4096+ks*1024+512):"memory");}
    asm volatile("s_waitcnt lgkmcnt(0)":::"memory");SBAR();
    #define PK(k) (bf16x8){lo[k][0],lo[k][1],lo[k][2],lo[k][3],hi[k][0],hi[k][1],hi[k][2],hi[k][3]}
    o[d0]=__builtin_amdgcn_mfma_f32_32x32x16_bf16(pa0,PK(0),o[d0],0,0,0);
    o[d0]=__builtin_amdgcn_mfma_f32_32x32x16_bf16(pa1,PK(1),o[d0],0,0,0);
    o[d0]=__builtin_amdgcn_mfma_f32_32x32x16_bf16(pa2,PK(2),o[d0],0,0,0);
    o[d0]=__builtin_amdgcn_mfma_f32_32x32x16_bf16(pa3,PK(3),o[d0],0,0,0);
    #undef PK
  }
}

#ifndef ATTN_STORE16
#define ATTN_STORE16(p,v) (*(u32x4*)(p)=(v))
#endif
template<int THRL> __device__ __forceinline__ void attn_unit(float sref,int q0,int NT,const bf16*Q,const bf16*__restrict__ Kh,const bf16*__restrict__ Vh,bf16*O,char*shm){
  const int tid=tid_fresh(),lane=tid&63,r32=lane&31,hi=lane>>5; const int wid=__builtin_amdgcn_readfirstlane(tid>>6);
  const bf16*Qw=Q+(long)(q0+wid*QBLK)*PQ;
  const unsigned lds0=(unsigned)(uintptr_t)shm;
  float*wsf=(float*)(shm+LDS_WS)+wid*64;
  const bf16*ksrc=Kh+(long)lane*PQ+wid*8;
  const bf16*vsrc=Vh+(long)(16*(wid&3)+(lane>>2))*PQ+(wid>>2)*32+(lane&3)*8;
  const unsigned kdst=lds0+LDS_K+wid*1024, vdst=lds0+LDS_V+wid*1024;
  #define DMA_K(t,slot) glds16(ksrc+(long)(t)*KVBLK*PQ,(unsigned)__builtin_amdgcn_readfirstlane(kdst+(slot)))
  #define DMA_V(t,slot) glds16(vsrc+(long)(t)*KVBLK*PQ,(unsigned)__builtin_amdgcn_readfirstlane(vdst+(slot)))
  const int vb0=(int)(lds0+LDS_V)+((lane>>4)&1)*32+(lane&3)*8+(4*hi+((lane&15)>>2))*64;
  const char*Kbase=shm+LDS_K; bf16x8 kf[8];
  const lds_cptr shm3=(lds_cptr)shm; const lds_cptr kp0=shm3+LDS_K+hi*1024+r32*16; const lds_cptr vp0=shm3+LDS_V+((lane>>4)&1)*32+(lane&3)*8+(4*hi+((lane&15)>>2))*64;
  DMA_K(0,0);DMA_V(0,0);DMA_K(1,SLOTB);
  bf16x8 qr[4];
  #pragma unroll
  for(int d0=0;d0<4;++d0)qr[d0]=*reinterpret_cast<const bf16x8*>(&Qw[(long)r32*PQ+d0*16+hi*8]);
  float mhat=0.f,l_reg=0.f;f32x16 o[2];o[0]=f32x16{};o[1]=f32x16{};f32x16 negm=f32x16{};asm volatile("":"+v"(negm));
  #define CMASK(P0,P1,t) do{}while(0)
  bool resc=false;
  #define START(P0,P1) do{ const float rm=FIXEDREF?sref:rowmax(P0,P1); resc=false; \
    { const float dl=rm; mhat=fadd_s(mhat,dl); \
      _Pragma("unroll") for(int r=0;r<16;++r){P0[r]=fsub_s(P0[r],dl);P1[r]=fsub_s(P1[r],dl);} \
      _Pragma("unroll") for(int r=0;r<16;++r)negm[r]=-mhat; asm volatile("":"+v"(negm)); } \
    _Pragma("unroll") for(int r=0;r<16;++r)P0[r]=__builtin_amdgcn_exp2f(P0[r]); }while(0)
  #define RESC() do{ if(resc){ asm volatile("s_waitcnt lgkmcnt(0)":::"memory"); \
      _Pragma("unroll") for(int d_=0;d_<2;++d_) _Pragma("unroll") for(int r=0;r<16;++r)o[d_][r]*=wsf[crow(r,hi)]; } }while(0)
  f32x16 pA0,pA1,pB0,pB1;
  int sl_prev=0,sl_cur=0,sl_next=SLOTB;
  #define ROT() do{sl_prev=sl_cur;sl_cur=sl_next;sl_next=(sl_next==(NSLOT-1)*SLOTB)?0:sl_next+SLOTB;}while(0)
  DMA_K(2,2*SLOTB);
  WAIT_BAR(3);
  qkt(pA0,pA1,Kbase,qr,negm,r32,hi);asm volatile("s_nop 15\n\ts_nop 7":"+v"(pA0),"+v"(pA1));CMASK(pA0,pA1,0);
  START(pA0,pA1);
  _Pragma("unroll") for(int r=0;r<16;++r)pA1[r]=__builtin_amdgcn_exp2f(pA1[r]);
  WAIT_BAR(0);
  DMA_K(3,0);DMA_V(1,SLOTB);
  ROT();
  kload8(kf,kp0+sl_cur);
  WAIT_BAR(2);
  s16x4 vlo[8],vhi[8]; u32x4 pw0,pw1,pw2,pw3;
  #define PKW(P,B) cvtpk_s(P[B],P[B+1])
  #define PAF(k) __builtin_bit_cast(bf16x8,pw##k)
  #define VFR(i) (bf16x8){vlo[i][0],vlo[i][1],vlo[i][2],vlo[i][3],vhi[i][0],vhi[i][1],vhi[i][2],vhi[i][3]}
  #define PIN(x) asm volatile("":"+v"(x))
  #define MX3(a,b,c) __builtin_fmaxf(__builtin_fmaxf((a),(b)),(c))
  #define GAPA(MF,A0,A1,A2,A3,W0,W1,PW) do{ MF; sacc+=A0; sacc+=A1; sacc+=A2; sacc+=A3; PIN(sacc); W0; W1; PIN(PW); SBAR(); }while(0)
  #define EX(v) __builtin_amdgcn_exp2f(v)
  #define GAPB(MF,X,B) do{ MF; X[B]=EX(X[B]); X[B+1]=EX(X[B+1]); X[B+2]=EX(X[B+2]); X[B+3]=EX(X[B+3]); PIN(X); SBAR(); }while(0)
  #define VRD(i) do{ vlo[i]=vtr(vp_+(((i)>>2)*4096+((i)&3)*1024)); vhi[i]=vtr(vp_+(((i)>>2)*4096+((i)&3)*1024+512)); }while(0)
  #define KRD(G,j) do{ if(G){ kload2(kf,kp0+sl_next,j); SBAR(); } }while(0)
  #define STEP(C0,C1,P0,P1,t,GK,GV,GL) do{ SBAR(); \
    const lds_cptr vp_=vp0+sl_prev; \
    VRD(0); SBAR(); float sacc=(P0[0]+P0[1]); \
    GAPA(C0=__builtin_amdgcn_mfma_f32_32x32x16_bf16(kf[0],qr[0],negm,0,0,0), P0[2],P0[3],P0[4],P0[5],     pw0[0]=PKW(P0,0), pw0[1]=PKW(P0,2), pw0); \
    VRD(4); SBAR(); GAPA(C1=__builtin_amdgcn_mfma_f32_32x32x16_bf16(kf[1],qr[0],negm,0,0,0), P0[6],P0[7],P0[8],P0[9],     pw0[2]=PKW(P0,4), pw0[3]=PKW(P0,6), pw0); \
    VRD(1); SBAR(); GAPA(C0=__builtin_amdgcn_mfma_f32_32x32x16_bf16(kf[2],qr[1],C0,0,0,0),   P0[10],P0[11],P0[12],P0[13], pw1[0]=PKW(P0,8), pw1[1]=PKW(P0,10), pw1); \
    VRD(5); SBAR(); GAPA(C1=__builtin_amdgcn_mfma_f32_32x32x16_bf16(kf[3],qr[1],C1,0,0,0),   P0[14],P0[15],P1[0],P1[1],   pw1[2]=PKW(P0,12),pw1[3]=PKW(P0,14), pw1); \
    VRD(2); SBAR(); GAPA(C0=__builtin_amdgcn_mfma_f32_32x32x16_bf16(kf[4],qr[2],C0,0,0,0),   P1[2],P1[3],P1[4],P1[5],     pw2[0]=PKW(P1,0), pw2[1]=PKW(P1,2), pw2); \
    VRD(6); SBAR(); GAPA(C1=__builtin_amdgcn_mfma_f32_32x32x16_bf16(kf[5],qr[2],C1,0,0,0),   P1[6],P1[7],P1[8],P1[9],     pw2[2]=PKW(P1,4), pw2[3]=PKW(P1,6), pw2); \
    VRD(3); SBAR(); GAPA(C0=__builtin_amdgcn_mfma_f32_32x32x16_bf16(kf[6],qr[3],C0,0,0,0),   P1[10],P1[11],P1[12],P1[13], pw3[0]=PKW(P1,8), pw3[1]=PKW(P1,10), pw3); \
    VRD(7); SBAR(); GAPA(C1=__builtin_amdgcn_mfma_f32_32x32x16_bf16(kf[7],qr[3],C1,0,0,0),   P1[14],P1[15],0.f,0.f,       pw3[2]=PKW(P1,12),pw3[3]=PKW(P1,14), pw3); \
    l_reg+=sacc; \
    if(GK){DMA_K((t)+3,sl_cur);} if(GV){DMA_V((t)+1,sl_next);} \
    CMASK(C0,C1,t); \
    { float a=MX3(C0[0],C0[1],C1[0]),b=MX3(C0[2],C0[3],C1[1]); a=MX3(a,C1[2],C1[3]); \
      _Pragma("unroll") for(int r=4;r<16;r+=4){a=MX3(a,C0[r],C0[r+1]);b=MX3(b,C0[r+2],C0[r+3]);a=MX3(a,C1[r],C1[r+1]);b=MX3(b,C1[r+2],C1[r+3]);} \
      float rm=__builtin_fmaxf(a,b); { auto rr=__builtin_amdgcn_permlane32_swap(__float_as_uint(rm),__float_as_uint(rm),false,false); rm=__builtin_fmaxf(__uint_as_float(rr[0]),__uint_as_float(rr[1])); } \
      resc=false; \
      if(!FIXEDREF&&__builtin_expect(__any(rm>(float)THRL),0)){ const float dl=__builtin_fmaxf(rm,0.f); mhat+=dl; \
        _Pragma("unroll") for(int r=0;r<16;++r){C0[r]-=dl;C1[r]-=dl;} \
        _Pragma("unroll") for(int r=0;r<16;++r)negm[r]=-mhat; asm volatile("":"+v"(negm)); \
        const float f=__builtin_amdgcn_exp2f(-dl); l_reg*=f; if(hi==0)wsf[r32]=f; resc=true; } } \
    SBAR(); \
    GAPB(o[0]=__builtin_amdgcn_mfma_f32_32x32x16_bf16(PAF(0),VFR(0),o[0],0,0,0), C0,0); \
    GAPB(o[1]=__builtin_amdgcn_mfma_f32_32x32x16_bf16(PAF(0),VFR(4),o[1],0,0,0), C0,4); \
    KRD(GL,0); GAPB(o[0]=__builtin_amdgcn_mfma_f32_32x32x16_bf16(PAF(1),VFR(1),o[0],0,0,0), C0,8); \
    KRD(GL,1); GAPB(o[1]=__builtin_amdgcn_mfma_f32_32x32x16_bf16(PAF(1),VFR(5),o[1],0,0,0), C0,12); \
    KRD(GL,2); GAPB(o[0]=__builtin_amdgcn_mfma_f32_32x32x16_bf16(PAF(2),VFR(2),o[0],0,0,0), C1,0); \
    KRD(GL,3); GAPB(o[1]=__builtin_amdgcn_mfma_f32_32x32x16_bf16(PAF(2),VFR(6),o[1],0,0,0), C1,4); \
    GAPB(o[0]=__builtin_amdgcn_mfma_f32_32x32x16_bf16(PAF(3),VFR(3),o[0],0,0,0), C1,8); \
    GAPB(o[1]=__builtin_amdgcn_mfma_f32_32x32x16_bf16(PAF(3),VFR(7),o[1],0,0,0), C1,12); \
    }while(0)
  int t=1;
  #undef CMASK
  #define CMASK(P0,P1,t) do{}while(0)
  for(;t+5<NT;t+=2){
    STEP(pB0,pB1,pA0,pA1,t,true,true,true);     WAIT_BAR(2); RESC(); ROT();
    STEP(pA0,pA1,pB0,pB1,t+1,true,true,true);   WAIT_BAR(2); RESC(); ROT();
  }
  #undef CMASK
  #define CMASK(P0,P1,t) do{}while(0)
  #define ENDW(tt) do{ if((tt)+3<NT){WAIT_BAR(2);} else if((tt)+2<NT){WAIT_BAR(1);} else {WAIT_BAR(0);} }while(0)
  for(;t+1<NT;t+=2){
    STEP(pB0,pB1,pA0,pA1,t,(t+3<NT),(t+1<NT),(t+1<NT));       ENDW(t);   RESC(); ROT();
    STEP(pA0,pA1,pB0,pB1,t+1,(t+4<NT),(t+2<NT),(t+2<NT));     ENDW(t+1); RESC(); ROT();
  }
  STEP(pB0,pB1,pA0,pA1,NT-1,false,false,false); RESC();
  { float sacc=pB0[0]+pB0[1]; _Pragma("unroll") for(int r=2;r<16;++r)sacc+=pB0[r]; _Pragma("unroll") for(int r=0;r<16;++r)sacc+=pB1[r]; l_reg+=sacc;
    pw0=(u32x4){PKW(pB0,0),PKW(pB0,2),PKW(pB0,4),PKW(pB0,6)};pw1=(u32x4){PKW(pB0,8),PKW(pB0,10),PKW(pB0,12),PKW(pB0,14)};pw2=(u32x4){PKW(pB1,0),PKW(pB1,2),PKW(pB1,4),PKW(pB1,6)};pw3=(u32x4){PKW(pB1,8),PKW(pB1,10),PKW(pB1,12),PKW(pB1,14)};
    SBAR(); pv(o,vb0+sl_cur,PAF(0),PAF(1),PAF(2),PAF(3)); }
  #undef PKW
  #undef PAF
  #undef VFR
  #undef PIN
  #undef MX3
  #undef GAPA
  #undef GAPB
  #undef EX
  #undef VRD
  #undef KRD
  #undef STEP
  #undef ENDW
  {auto rr=__builtin_amdgcn_permlane32_swap(__float_as_uint(l_reg),__float_as_uint(l_reg),false,false);l_reg=__uint_as_float(rr[0])+__uint_as_float(rr[1]);}
  if(hi==0)wsf[32+r32]=l_reg;asm volatile("s_waitcnt lgkmcnt(0)":::"memory");
  float rli[16];
  #pragma unroll
  for(int r=0;r<16;++r)rli[r]=__builtin_amdgcn_rcpf(wsf[32+crow(r,hi)]);
  bf16*Ow=O+(long)(q0+wid*QBLK)*PO;
  { bf16*stg=(bf16*)(shm+LDS_OST)+wid*2048;
    #pragma unroll
    for(int r=0;r<16;++r){const int orow=crow(r,hi);
      #pragma unroll
      for(int d0=0;d0<2;++d0)stg[orow*64+d0*32+r32]=__float2bfloat16(o[d0][r]*rli[r]);}
    asm volatile("s_waitcnt lgkmcnt(0)":::"memory");
    #pragma unroll
    for(int i=0;i<4;++i){const int row=i*8+(lane>>3),ch=lane&7; const u32x4 v=*(const u32x4*)(stg+row*64+ch*8); ATTN_STORE16(Ow+(long)row*PO+ch*8,v);} }
  asm volatile("s_waitcnt lgkmcnt(0)\n\ts_barrier":::"memory");
  #undef DMA_K
  #undef DMA_V
  #undef CMASK
  #undef START
  #undef RESC
  #undef ROT
}
constexpr int ATTN_LDS_BYTES=LDS_BYTES;
#undef SBAR
#undef WAIT_BAR
}

DEV void phase_attn_fast(const Ctx& X, char* shm) {
    typedef attn_body::bf16 abf;
    const abf* P0 = (const abf*)X.BIG; abf* CAT = (abf*)X.XN;
    const int G = gridDim.x, bx = blockIdx.x, x8 = (G % 8 == 0), vcu = x8 ? (bx % 8) * (G / 8) + bx / 8 : bx;
    const int per = (512 + G - 1) / G;
    float mq = 0.f, mk = 0.f;
    for (int d = 0; d < 64; ++d) { mq = fmaxf(mq, fabsf(X.ab_q_norm_g[d])); mk = fmaxf(mk, fabsf(X.ab_k_norm_g[d])); }
    const float sref = 1.02f * C2 * 64.f * mq * mk;
    for (int i = 0; i < per; ++i) {
        const int u = vcu * per + i; if (u >= 512) break;
        const int h = u >> 6, qb = u & 63;
        attn_body::attn_unit<8>(sref, NCTX + qb * 256, R / 64, P0 + 1024 + h * 64, P0 + 1536 + (h >> 2) * 64, P0 + 1664 + (h >> 2) * 64, CAT + 512 + h * 64, shm);
    }
    for (int h = 0; h < 8; ++h) if (vcu == (x8 ? h * (G / 8) : h))
        attn_body::attn_unit<8>(sref, 0, NCTX / 64, P0 + 1024 + h * 64, P0 + 1536 + (h >> 2) * 64, P0 + 1664 + (h >> 2) * 64, CAT + 512 + h * 64, shm);
}


#define LAS __attribute__((address_space(3)))
typedef short v4i16_t __attribute__((ext_vector_type(4)));
typedef LAS unsigned char* lptr;
DEV bf16x8 mk8(v4i16_t a, v4i16_t b) { return __builtin_shufflevector(a, b, 0, 1, 2, 3, 4, 5, 6, 7); }
DEV bf16x8 tr_frag(lptr tile, int stride, int k0, int x0, int lane) {
    const int g = lane >> 4, q = (lane & 15) >> 2, p = lane & 3;
    lptr a = tile + (k0 + 8 * g + q) * stride + (x0 + 4 * p) * 2;
    const v4i16_t v0 = __builtin_amdgcn_ds_read_tr16_b64_v4i16((LAS v4i16_t*)a), v1 = __builtin_amdgcn_ds_read_tr16_b64_v4i16((LAS v4i16_t*)(a + 4 * stride));
    return mk8(v0, v1);
}
#define MFMA16(a, b, c) __builtin_amdgcn_mfma_f32_16x16x32_bf16(a, b, c, 0, 0, 0)

DEV void phase_sgu_fast(const Ctx& X, lptr L) {
    const u16* P0 = X.BIG; u16* CAT = X.XN; constexpr int SV = 528;
    const int lane = X.lane, w = X.wave, fi = lane & 15, fg = lane >> 4;
    for (int it = blockIdx.x; it < NPC * 2; it += gridDim.x) {
        const int pc = it >> 1, half = it & 1;
        __syncthreads();
        for (int c = X.tid; c < 128 * 32; c += NTHR) { const int row = c >> 5, ch = c & 31;
            *(LAS u32x4*)(L + row * SV + ch * 16) = *(const u32x4*)(P0 + (size_t)(pc * 128 + row) * EVEN_IN + 512 + half * 256 + ch * 8); }
        __syncthreads();
        const int gl = w >> 1, mh = w & 1, g = half * 4 + gl;
        f32x4 acc[4][4];
#pragma unroll
        for (int a = 0; a < 4; ++a)
#pragma unroll
            for (int b = 0; b < 4; ++b) acc[a][b] = (f32x4){0.f, 0.f, 0.f, 0.f};
        const u16* Wg = X.SPW + (size_t)g * 128 * 128 + (size_t)(64 * mh + fi) * 128 + 8 * fg;
#pragma unroll
        for (int ks = 0; ks < 4; ++ks) {
            bf16x8 af[4], bfr[4];
#pragma unroll
            for (int mt = 0; mt < 4; ++mt) af[mt] = *(const bf16x8*)(Wg + (size_t)(16 * mt) * 128 + 32 * ks);
#pragma unroll
            for (int nt = 0; nt < 4; ++nt) bfr[nt] = tr_frag(L, SV, 32 * ks, gl * 64 + 16 * nt, lane);
#pragma unroll
            for (int mt = 0; mt < 4; ++mt)
#pragma unroll
                for (int nt = 0; nt < 4; ++nt) acc[mt][nt] = MFMA16(af[mt], bfr[nt], acc[mt][nt]);
        }
#pragma unroll
        for (int mt = 0; mt < 4; ++mt)
#pragma unroll
            for (int j = 0; j < 4; ++j) {
                const int t = 64 * mh + 16 * mt + 4 * fg + j; const size_t row = (size_t)pc * 128 + t; const float bias = X.ab_spatial_b[g * 128 + t];
#pragma unroll
                for (int nt = 0; nt < 4; ++nt) { const int col = g * 64 + 16 * nt + fi; CAT[row * D + col] = f2bf(bf2f(P0[row * EVEN_IN + col]) * (acc[mt][nt][j] + bias)); }
            }
    }
}

DEV void phase_m1_fast(const Ctx& X, lptr L) {
    const u16* PM = X.BIG; const u16* QKC = X.XN; constexpr int SV = 272, SK = 144;
    lptr LV = L, LK0 = L + 128 * SV, LK1 = LK0 + 128 * SK;
    const int lane = X.lane, w = X.wave, fi = lane & 15, fg = lane >> 4;
    for (int it = blockIdx.x; it < 8 * NPC; it += gridDim.x) {
        const int h = it / NPC, pc = it % NPC, item0 = item_of(0, h, pc), item1 = item_of(1, h, pc);
        __syncthreads();
        for (int c = X.tid; c < 128 * 16; c += NTHR) { const int row = c >> 4, ch = c & 15;
            *(LAS u32x4*)(LV + row * SV + ch * 16) = *(const u32x4*)(PM + (size_t)(pc * 128 + row) * PMW + 1024 + h * 128 + ch * 8); }
        for (int c = X.tid; c < 128 * 8; c += NTHR) { const int row = c >> 3, ch = c & 7;
            const bf16x8 kv = *(const bf16x8*)(QKC + (size_t)(pc * 128 + row) * D + 512 + h * 64 + ch * 8);
            const float e0 = X.EE[(size_t)item0 * 128 + row], e1 = X.EE[(size_t)item1 * 128 + row];
            float f[8];
#pragma unroll
            for (int j = 0; j < 8; ++j) f[j] = bf2f((u16)kv[j]);
            u32x4 o0, o1;
            o0.x = pk2(f[0] * e0, f[1] * e0); o0.y = pk2(f[2] * e0, f[3] * e0); o0.z = pk2(f[4] * e0, f[5] * e0); o0.w = pk2(f[6] * e0, f[7] * e0);
            o1.x = pk2(f[0] * e1, f[1] * e1); o1.y = pk2(f[2] * e1, f[3] * e1); o1.z = pk2(f[4] * e1, f[5] * e1); o1.w = pk2(f[6] * e1, f[7] * e1);
            *(LAS u32x4*)(LK0 + row * SK + ch * 16) = o0; *(LAS u32x4*)(LK1 + row * SK + ch * 16) = o1; }
        __syncthreads();
        const int d = w >> 2, vq = w & 3, item = d ? item1 : item0; lptr LK = d ? LK1 : LK0;
        f32x4 acc[2][4];
#pragma unroll
        for (int a = 0; a < 2; ++a)
#pragma unroll
            for (int b = 0; b < 4; ++b) acc[a][b] = (f32x4){0.f, 0.f, 0.f, 0.f};
#pragma unroll
        for (int ks = 0; ks < 4; ++ks) {
            bf16x8 af[2], bfr[4];
#pragma unroll
            for (int mt = 0; mt < 2; ++mt) af[mt] = tr_frag(LV, SV, 32 * ks, 32 * vq + 16 * mt, lane);
#pragma unroll
            for (int nt = 0; nt < 4; ++nt) bfr[nt] = tr_frag(LK, SK, 32 * ks, 16 * nt, lane);
#pragma unroll
            for (int mt = 0; mt < 2; ++mt)
#pragma unroll
                for (int nt = 0; nt < 4; ++nt) acc[mt][nt] = MFMA16(af[mt], bfr[nt], acc[mt][nt]);
        }
        float* co = X.CLOC + (size_t)item * 8192;
#pragma unroll
        for (int mt = 0; mt < 2; ++mt)
#pragma unroll
            for (int nt = 0; nt < 4; ++nt)
#pragma unroll
                for (int j = 0; j < 4; ++j) co[(32 * vq + 16 * mt + 4 * fg + j) * 64 + 16 * nt + fi] = acc[mt][nt][j];
        if (X.tid < 128) { const int dd = X.tid >> 6, kk = X.tid & 63; lptr lk = dd ? LK1 : LK0; float s = 0.f;
            for (int p = 0; p < 128; ++p) s += bf2f(*(LAS u16*)(lk + p * SK + kk * 2));
            X.NLOC[(size_t)(dd ? item1 : item0) * 64 + kk] = s; }
    }
}

DEV void phase_m3_fast(const Ctx& X, lptr L) {
    u16* PM = X.BIG; const u16* QKC = X.XN; constexpr int SV = 272, SC = 144, SP = 272;
    lptr LV = L, LC0 = L + 128 * SV, LC1 = LC0 + 128 * SC, LNI = LC1 + 128 * SC  , LP = LNI + 256;
    const int lane = X.lane, w = X.wave, fi = lane & 15, fg = lane >> 4;
    lptr LPw = LP + w * (16 * SP);
    for (int it = blockIdx.x; it < 8 * (NLAT / 128); it += gridDim.x) {
        const int h = it / (NLAT / 128), pc = 2 + it % (NLAT / 128); const size_t r0 = (size_t)pc * 128;
        __syncthreads();
        for (int c = X.tid; c < 128 * 16; c += NTHR) { const int row = c >> 4, ch = c & 15;
            *(LAS u32x4*)(LV + row * SV + ch * 16) = *(const u32x4*)(PM + (r0 + row) * PMW + 1024 + h * 128 + ch * 8); }
        for (int c = X.tid; c < 2 * 128 * 8; c += NTHR) { const int dd = c >> 10, row = (c >> 3) & 127, ch = c & 7;
            const float* src = X.CLOC + (size_t)item_of(dd, h, pc) * 8192 + row * 64 + ch * 8; const f32x4 a = *(const f32x4*)src, b = *(const f32x4*)(src + 4);
            u32x4 o; o.x = pk2(a.x, a.y); o.y = pk2(a.z, a.w); o.z = pk2(b.x, b.y); o.w = pk2(b.z, b.w);
            *(LAS u32x4*)((dd ? LC1 : LC0) + row * SC + ch * 16) = o; }
        if (X.tid < 128) { const int dd = X.tid >> 6, kk = X.tid & 63; *(LAS u16*)(LNI + (dd * 64 + kk) * 2) = f2bf(X.NLOC[(size_t)item_of(dd, h, pc) * 64 + kk]); }
        __syncthreads();
        bf16x8 qf[2];
#pragma unroll
        for (int ks = 0; ks < 2; ++ks) qf[ks] = *(const bf16x8*)(QKC + (r0 + 16 * w + fi) * D + h * 64 + 32 * ks + 8 * fg);
        f32x4 hs[8];
#pragma unroll
        for (int nt = 0; nt < 8; ++nt) hs[nt] = (f32x4){0.f, 0.f, 0.f, 0.f};
#pragma unroll 1
        for (int d = 0; d < 2; ++d) {
            const int item = item_of(d, h, pc);
            const float* bb = X.BB + (size_t)item * 128; const float* li = X.LI + (size_t)item * 128; const float* rm = X.RM + (size_t)item * 128;
            const float m_in = X.MIN[item];
            f32x4 s[8];
#pragma unroll
            for (int nt = 0; nt < 8; ++nt) {
                s[nt] = (f32x4){0.f, 0.f, 0.f, 0.f};
#pragma unroll
                for (int ks = 0; ks < 2; ++ks) { const bf16x8 kf = *(const bf16x8*)(QKC + (r0 + 16 * nt + fi) * D + 512 + h * 64 + 32 * ks + 8 * fg); s[nt] = MFMA16(qf[ks], kf, s[nt]); }
            }
            float mj[4], bj[4];
#pragma unroll
            for (int jj = 0; jj < 4; ++jj) { const int j = 16 * w + 4 * fg + jj; mj[jj] = fmaxf(m_in, rm[j]); bj[jj] = bb[j]; }
#pragma unroll
            for (int nt = 0; nt < 8; ++nt) {
                const int sidx = 16 * nt + fi; const float cs = li[sidx] - bb[sidx];
                float pv[4];
#pragma unroll
                for (int jj = 0; jj < 4; ++jj) { const int j = 16 * w + 4 * fg + jj; const bool valid = d == 0 ? (sidx <= j) : (sidx >= j); pv[jj] = valid ? s[nt][jj] * __expf(cs - mj[jj]) : 0.f; }
#pragma unroll
                for (int jj = 0; jj < 4; ++jj) *(LAS u16*)(LPw + (4 * fg + jj) * SP + sidx * 2) = f2bf(pv[jj]);
            }
            LDS_FENCE(); __syncthreads();
            const float arow = __expf(m_in - fmaxf(m_in, rm[16 * w + fi]));
            bf16x8 aq[2];
#pragma unroll
            for (int ks = 0; ks < 2; ++ks)
#pragma unroll
                for (int e = 0; e < 8; ++e) aq[ks][e] = (short)f2bf(bf2f((u16)qf[ks][e]) * arow);
            f32x4 num[8], den = (f32x4){0.f, 0.f, 0.f, 0.f};
#pragma unroll
            for (int nt = 0; nt < 8; ++nt) num[nt] = (f32x4){0.f, 0.f, 0.f, 0.f};
            const short one = fi == 0 ? (short)0x3F80 : (short)0;
            const bf16x8 ones = (bf16x8){one, one, one, one, one, one, one, one};
#pragma unroll
            for (int ks = 0; ks < 4; ++ks) {
                const bf16x8 pf = *(LAS bf16x8*)(LPw + fi * SP + (32 * ks + 8 * fg) * 2);
#pragma unroll
                for (int nt = 0; nt < 8; ++nt) num[nt] = MFMA16(pf, tr_frag(LV, SV, 32 * ks, 16 * nt, lane), num[nt]);
                den = MFMA16(pf, ones, den);
            }
            lptr LC = d ? LC1 : LC0;
#pragma unroll
            for (int ks = 0; ks < 2; ++ks) {
#pragma unroll
                for (int nt = 0; nt < 8; ++nt) num[nt] = MFMA16(aq[ks], *(LAS bf16x8*)(LC + (16 * nt + fi) * SC + (32 * ks + 8 * fg) * 2), num[nt]);
                bf16x8 nf = *(LAS bf16x8*)(LNI + (d * 64 + 32 * ks + 8 * fg) * 2);
                if (fi != 0) nf = (bf16x8){0, 0, 0, 0, 0, 0, 0, 0};
                den = MFMA16(aq[ks], nf, den);
            }
#pragma unroll
            for (int jj = 0; jj < 4; ++jj) {
                const float dn = __shfl(den[jj], lane & 48);
                const float inv = 1.f / fmaxf(fabsf(dn), __expf(-(bj[jj] + mj[jj])));
#pragma unroll
                for (int nt = 0; nt < 8; ++nt) hs[nt][jj] += num[nt][jj] * inv;
            }
            LDS_FENCE(); __syncthreads();
        }
#pragma unroll
        for (int jj = 0; jj < 4; ++jj) {
            float ss = 0.f;
#pragma unroll
            for (int nt = 0; nt < 8; ++nt) ss += hs[nt][jj] * hs[nt][jj];
            ss += __shfl_xor(ss, 1); ss += __shfl_xor(ss, 2); ss += __shfl_xor(ss, 4); ss += __shfl_xor(ss, 8);
            const float rs = rsqrtf(ss * (1.f / 128) + EPS);
            u16* prow = PM + (r0 + 16 * w + 4 * fg + jj) * PMW;
#pragma unroll
            for (int nt = 0; nt < 8; ++nt) { const int v = 16 * nt + fi; prow[h * 128 + v] = f2bf(hs[nt][jj] * rs * X.ml_out_norm_g[h * 128 + v] * sigmoid_f(bf2f(prow[2048 + h * 128 + v]))); }
        }
    }
}


#define XB_TMO      128
#define XB_XCNT(j)  (256  + 64 * (j))
#define XB_XSUB(j)  (1280 + 64 * (j))
#define XB_XGEN(j)  (2304 + 64 * (j))
#define XB_TOP      3328
#define XB_TOPGEN   3392
#define XCD_BAR_WORDS 3456
#define XB_SPIN_CAP (1u << 22)

__device__ __forceinline__ unsigned xb_ld(unsigned* p)              { return __hip_atomic_load(p, __ATOMIC_RELAXED, __HIP_MEMORY_SCOPE_AGENT); }
__device__ __forceinline__ unsigned xb_add(unsigned* p, unsigned v) { return __hip_atomic_fetch_add(p, v, __ATOMIC_RELAXED, __HIP_MEMORY_SCOPE_AGENT); }
__device__ __forceinline__ unsigned xb_xcc_id() { return (unsigned)__builtin_amdgcn_s_getreg((3 << 11) | 20) & 0xFu; }
#define XB_SPIN(cond, bar) do { unsigned _sp = 0; while (cond) { __builtin_amdgcn_s_sleep(1); \
    if ((++_sp & 255u) == 0u) { if (xb_ld(&(bar)[XB_TMO])) break; if (_sp > XB_SPIN_CAP) { atomicAdd(&(bar)[XB_TMO], 1u); break; } } } } while (0)

struct XcdBarrier {
    unsigned* bar; unsigned x;
    volatile LAS unsigned* st;
};

__device__ __forceinline__ XcdBarrier xcd_barrier_post(unsigned* bar, volatile LAS unsigned* st) {
    XcdBarrier b; b.bar = bar; b.x = xb_xcc_id(); b.st = st;
    if (threadIdx.x == 0) (void)xb_add(&bar[XB_XCNT(b.x)], 1u);
    return b;
}
__device__ __forceinline__ void xcd_barrier_complete(unsigned* bar, unsigned x, unsigned& nloc, unsigned& nx) {
    const unsigned G = gridDim.x * gridDim.y * gridDim.z;
    unsigned sum, cnt, mine, sp = 0u;
    for (;;) {
        sum = 0u; cnt = 0u; mine = 0u;
#pragma unroll
        for (unsigned j = 0; j < 16; ++j) { const unsigned c = xb_ld(&bar[XB_XCNT(j)]); sum += c; cnt += (c > 0u) ? 1u : 0u; mine = (j == x) ? c : mine; }
        if (sum == G) break;
        __builtin_amdgcn_s_sleep(1);
        if ((++sp & 255u) == 0u) { if (xb_ld(&bar[XB_TMO])) break; if (sp > XB_SPIN_CAP) { atomicAdd(&bar[XB_TMO], 1u); break; } }
    }
    nloc = mine > 0u ? mine : 1u; nx = cnt > 0u ? cnt : 1u;
}

__device__ __forceinline__ void xcd_barrier(const XcdBarrier& b) {
    asm volatile("s_waitcnt vmcnt(0)" ::: "memory");
    __syncthreads();
    if (threadIdx.x == 0) {
        unsigned* bar = b.bar;
        __builtin_amdgcn_s_waitcnt(0);
        unsigned nloc = b.st[0], nx = b.st[1];
        if (nloc == 0u) { xcd_barrier_complete(bar, b.x, nloc, nx); b.st[0] = nloc; b.st[1] = nx; }
        const unsigned old = xb_add(&bar[XB_XSUB(b.x)], 1u);
        const unsigned gen = old / nloc;
        if (old + 1u == (gen + 1u) * nloc) {
            __builtin_amdgcn_fence(__ATOMIC_RELEASE, "agent");
            asm volatile("s_waitcnt vmcnt(0)" ::: "memory");
            const unsigned og = xb_add(&bar[XB_TOP], 1u);
            const unsigned tg = og / nx;
            if (og + 1u == (tg + 1u) * nx) xb_add(&bar[XB_TOPGEN], 1u);
            else XB_SPIN(xb_ld(&bar[XB_TOPGEN]) == tg, bar);
            __builtin_amdgcn_fence(__ATOMIC_ACQUIRE, "agent");
            xb_add(&bar[XB_XGEN(b.x)], 1u);
            asm volatile("s_waitcnt vmcnt(0)" ::: "memory");
        } else {
            XB_SPIN(xb_ld(&bar[XB_XGEN(b.x)]) == gen, bar);
            __builtin_amdgcn_fence(__ATOMIC_ACQUIRE, "agent");
            asm volatile("s_waitcnt vmcnt(0)" ::: "memory");
        }
    }
    __syncthreads();
}

__global__ void __launch_bounds__(NTHR, 2) fwd_kernel(Args args) {
    extern __shared__ __attribute__((aligned(16))) unsigned char lds[];
    cg::grid_group grid = cg::this_grid();
    Ctx X;
    X.x = args.in[0]; X.c = args.in[1]; X.ctx = args.in[2]; X.c_ctx = args.in[3]; X.mod_w = args.in[4]; X.mod_b = args.in[5]; X.norm_g = args.in[6];
    X.ffn_w13 = args.in[7]; X.ffn_w2 = args.in[8]; X.ab_w_in = args.in[9]; X.ab_gate_norm_g = args.in[10]; X.ab_spatial_w = args.in[11]; X.ab_spatial_b = args.in[12];
    X.ab_q_norm_g = args.in[13]; X.ab_k_norm_g = args.in[14]; X.ab_w_out = args.in[15]; X.ml_w_in = args.in[16]; X.ml_conv_w = args.in[17]; X.ml_gate_b = args.in[18];
    X.ml_out_norm_g = args.in[19]; X.ml_w_out = args.in[20]; X.final_norm_g = args.in[21];
    X.out = args.out; unsigned char* ws = args.ws;
    X.MV = (float*)(ws + WS_MV); X.ROPE = (float*)(ws + WS_MV + 160 * KiB);
    X.MLOC = (float*)(ws + WS_MISC); X.BLAST = X.MLOC + 4096; X.MIN = X.MLOC + 8192; X.NLOC = X.MLOC + 16384;
    X.BB = (float*)(ws + WS_GS); X.LI = X.BB + NITEM * 128; X.EE = X.LI + NITEM * 128; X.RM = X.EE + NITEM * 128;
    X.G = (float*)(ws + WS_G); X.H = (float*)(ws + WS_H); X.CLOC = (float*)(ws + WS_CLOC); X.RAW = (u16*)(ws + WS_CLOC);
    X.W13T = (u16*)(ws + WS_W13T); X.W2T = (u16*)(ws + WS_W2T); X.ABIN = (u16*)(ws + WS_ABIN); X.ABOUT = (u16*)(ws + WS_ABOUT);
    X.MLIN = (u16*)(ws + WS_MLIN); X.MLOUT = (u16*)(ws + WS_MLOUT); X.SPW = (u16*)(ws + WS_SPW); X.XN = (u16*)(ws + WS_XN); X.BIG = (u16*)(ws + WS_BIG);
#define SET_TID() do { X.tid = tid_fresh(); X.lane = X.tid & 63; X.wave = __builtin_amdgcn_readfirstlane(X.tid >> 6); X.gw = blockIdx.x * NWAVES + X.wave; X.gtid = blockIdx.x * NTHR + X.tid; } while (0)
    SET_TID(); X.NGW = gridDim.x * NWAVES; X.NT = gridDim.x * NTHR;
    X.lds = lds;
    const int lo = args.ph_lo, hi = args.ph_hi;
    volatile LAS unsigned* bst = (volatile LAS unsigned*)((lptr)lds + (LDS_BYTES - 64));
    if (X.tid < 2) bst[X.tid] = 0u;
    __syncthreads();
    const XcdBarrier xbar = xcd_barrier_post((unsigned*)(ws + WS_BAR), bst);
    int ph = 0;
#define PH_BEGIN if (lo <= ph && ph < hi) { SET_TID();
#define GSYNC() do { __builtin_amdgcn_fence(__ATOMIC_RELEASE, "agent"); asm volatile("s_waitcnt vmcnt(0) lgkmcnt(0)" ::: "memory"); grid.sync(); \
        __builtin_amdgcn_fence(__ATOMIC_ACQUIRE, "agent"); asm volatile("s_waitcnt vmcnt(0)" ::: "memory"); __syncthreads(); } while (0)
#define PH_END } if (lo <= ph && ph + 1 < hi) { if (lo < 0) grid.sync(); else { xcd_barrier(xbar); if (PROBE_REP & 128) xcd_barrier(xbar); } } ++ph;
    const float* MVL0 = X.MV; const float* MVC0 = X.MV + 9216; const float* MVL1 = X.MV + 2 * 9216; const float* MVC1 = X.MV + 3 * 9216;

    PH_BEGIN REPN(1) { __syncthreads(); phase_prep(X); } PH_END
#define FGEMM(EpiT, epi, Aptr, lda_, Btptr, rows, pm0_, N_, K_) { pg8::Gemm g_{Aptr, lda_, Btptr, K_, rows, N_, K_}; pg8::Order S_; S_.init(rows, N_, (int)gridDim.x, (int)blockIdx.x, pm0_); \
        const EpiT e_ = epi; pg8::gemm_phase<EpiT, pg8::Order, true, true>((PG8_LAS unsigned char*)lds, g_, S_, e_); }
#define NGEMM(site_, mode_, MVOFF_, SHOFF_, NGOFF_, FROM_IN_, MUL2_, ngbase_, Aptr, lda_, Btptr, K_) { pg8::Gemm g_{Aptr, lda_, Btptr, K_, NLAT, D, K_}; pg8::Order S_; S_.init(NLAT, D, (int)gridDim.x, (int)blockIdx.x, 1); \
        typedef EpiResidNorm<mode_, site_, MVOFF_, SHOFF_, NGOFF_, FROM_IN_, MUL2_> EN_; const EN_ e_{ws, ngbase_, X.x, X.out}; \
        pg8::gemm_phase<EN_, pg8::Order, false, true>((PG8_LAS unsigned char*)lds, g_, S_, e_); }
#define KSGEMM(Aptr, lda_, Btptr, ldb_, S_, kc_, mvc_, mul_) { pg8::Gemm g_{Aptr, lda_, Btptr, ldb_, 256, D, kc_}; pg8::OrderKS S2_; S2_.init(D, S_, kc_, (int)gridDim.x, (int)blockIdx.x); \
        const EpiPartial e_{X.CLOC, mvc_, mul_, kc_}; pg8::gemm_phase<EpiPartial, pg8::OrderKS, true, true>((PG8_LAS unsigned char*)lds, g_, S2_, e_); }
#define FFN_UP(idx, rows, pm0_) PH_BEGIN REPN(64) if (FASTG & 1) { FGEMM(EpiSwiGLU, (EpiSwiGLU{X.BIG}), X.XN, D, X.W13T + (size_t)(idx) * F2 * D, rows, pm0_, F2, D) \
            if (PREP_DEFER && (idx) < 3) { const int nwg_ = ((rows) / 256) * (F2 / 256), rem_ = nwg_ % (int)gridDim.x; \
                if (rem_ != 0 && (int)blockIdx.x >= rem_) prep_group(X, (idx) + 1, ((int)blockIdx.x - rem_) * NWAVES + X.wave, ((int)gridDim.x - rem_) * NWAVES); \
                else if (rem_ == 0) prep_group(X, (idx) + 1, X.gw, X.NGW); } } \
        else ngemm<true>(X, X.XN, D, X.W13T + (size_t)(idx) * F2 * D, D, (pm0_) * 256, rows, F2, FSwiglu{X.BIG}); PH_END
#define FFN_DOWN(idx, rows, pm0_, from_in, mvl_, mvc_, site_, mode_, MVOFF_, SHOFF_, NGOFF_, ngbase_) PH_BEGIN if (FASTG & 2) { \
            if (NFUSE) NGEMM(site_, mode_, MVOFF_, SHOFF_, NGOFF_, from_in, 1, ngbase_, X.BIG, FH, X.W2T + (size_t)(idx) * D * FH, FH) \
            else FGEMM(EpiResid, (EpiResid{(from_in) ? X.ctx : X.H, (from_in) ? X.x : X.H + (size_t)NCTX * D, X.H, mvl_, mvc_, 0.5f}), X.BIG, FH, X.W2T + (size_t)(idx) * D * FH, (KSPLIT ? NLAT : rows), (KSPLIT ? 1 : pm0_), D, FH) \
            if (KSPLIT && (pm0_) == 0) KSGEMM(X.BIG, FH, X.W2T + (size_t)(idx) * D * FH, FH, 11, 256, mvc_, 0.5f) \
            } \
        else ngemm<false>(X, X.BIG, FH, X.W2T + (size_t)(idx) * D * FH, FH, (pm0_) * 256, rows, D, FResid{&X, from_in, mvl_, mvc_, 0.5f}); PH_END
    PH_BEGIN REPN(2) phase_norm(X, 0, 0, true, 0); PH_END
    FFN_UP(0, R, 0)
    FFN_DOWN(0, R, 0, true, MVL0 + 2 * D, MVC0 + 2 * D, 0, 0, 2 * D, 3 * D, 1 * D, X.norm_g)
    PH_BEGIN phase_norm(X, 0, 1, false, 0, KSPLIT ? 11 : 0, NFUSE ? NCTX : R); PH_END
    if (FASTG & 4) {
        PH_BEGIN REPN(1024) FGEMM(EpiAB, (EpiAB{X.BIG, X.ab_gate_norm_g, X.ab_q_norm_g, X.ab_k_norm_g, X.ROPE}), X.XN, D, X.ABIN, R, 0, EVEN_IN, D) PH_END
    } else {
        PH_BEGIN ngemm<false>(X, X.XN, D, X.ABIN, D, 0, R, EVEN_IN, FRawAB{X.RAW}); PH_END
        PH_BEGIN phase_abpost(X); PH_END
    }
    PH_BEGIN REPN(4) { if (FASTM & 1) phase_sgu_fast(X, (lptr)lds); else phase_sgu_naive(X);
        __syncthreads();
        if (FASTA) phase_attn_fast(X, (char*)lds); else phase_attn_naive(X); } PH_END
    PH_BEGIN if (FASTG & 8) { if (NFUSE) NGEMM(1, 0, 5 * D, 6 * D, 2 * D, false, 2, X.norm_g, X.XN, D, X.ABOUT, D)
            else FGEMM(EpiResid, (EpiResid{X.H, X.H + (size_t)NCTX * D, X.H, MVL0 + 5 * D, MVC0 + 5 * D, 1.f}), X.XN, D, X.ABOUT, (KSPLIT ? NLAT : R), (KSPLIT ? 1 : 0), D, D)
            if (KSPLIT) KSGEMM(X.XN, D, X.ABOUT, D, 4, 256, MVC0 + 5 * D, 1.f) }
        else ngemm<false>(X, X.XN, D, X.ABOUT, D, 0, R, D, FResid{&X, false, MVL0 + 5 * D, MVC0 + 5 * D, 1.f}); PH_END
    PH_BEGIN phase_norm(X, 0, 2, false, 0, KSPLIT ? 4 : 0, NFUSE ? NCTX : R); PH_END
    FFN_UP(1, R, 0)
    FFN_DOWN(1, R, 0, false, MVL0 + 8 * D, MVC0 + 8 * D, 2, 0, 8 * D, 2 * 9216, 3 * D, X.norm_g)
    PH_BEGIN phase_norm(X, 1, 0, false, 0, KSPLIT ? 11 : 0, NFUSE ? NCTX : R); PH_END
    FFN_UP(2, R, 0)
    FFN_DOWN(2, R, 0, false, MVL1 + 2 * D, MVC1 + 2 * D, 3, 0, 2 * 9216 + 2 * D, 2 * 9216 + 3 * D, 4 * D, X.norm_g)
    PH_BEGIN phase_norm(X, 1, 1, false, 0, KSPLIT ? 11 : 0, NFUSE ? NCTX : R); PH_END
    PH_BEGIN REPN(1024) if (FASTG & 16) FGEMM(EpiML, (EpiML{X.BIG, X.G, X.ml_gate_b}), X.XN, D, X.MLIN, R, 0, ODD_PAD, D)
        else ngemm<false>(X, X.XN, D, X.MLIN, D, 0, R, ODD_PAD, FML{X.BIG, X.G, X.ml_gate_b}); PH_END
    PH_BEGIN REPN(8) phase_x1(X); PH_END
    for (int rr_ = 0; rr_ < ((PROBE_REP & 256) ? 2 : 1); ++rr_) {
    PH_BEGIN REPN(16) { if (FASTM & 2) phase_m1_fast(X, (lptr)lds); else phase_m1_naive(X); } PH_END
    PH_BEGIN phase_m2(X); PH_END
    }
    if (FASTM & 4) { PH_BEGIN REPN(32) phase_m3_fast(X, (lptr)lds); PH_END }
    else { PH_BEGIN phase_m3_naive(X); PH_END
    PH_BEGIN phase_m3post(X); PH_END }
    PH_BEGIN if (FASTG & 8) { if (NFUSE) NGEMM(4, 0, 2 * 9216 + 5 * D, 2 * 9216 + 6 * D, 5 * D, false, 2, X.norm_g, X.BIG, PMW, X.MLOUT, D)
            else FGEMM(EpiResid, (EpiResid{X.H, X.H + (size_t)NCTX * D, X.H, MVL1 + 5 * D, MVC1 + 5 * D, 1.f}), X.BIG, PMW, X.MLOUT, NLAT, 1, D, D) }
        else ngemm<false>(X, X.BIG, PMW, X.MLOUT, D, NCTX, NLAT, D, FResid{&X, false, MVL1 + 5 * D, MVC1 + 5 * D, 1.f}); PH_END
    if (!NFUSE) { PH_BEGIN REPN(2) phase_norm(X, 1, 2, false, NCTX); PH_END }
    FFN_UP(3, NLAT, 1)
    FFN_DOWN(3, NLAT, 1, false, MVL1 + 8 * D, MVC1 + 8 * D, 5, 1, 2 * 9216 + 8 * D, 0, 0, X.final_norm_g)
    if (!NFUSE) { PH_BEGIN phase_final(X); PH_END }
}
constexpr int N_PHASES = 27 - ((FASTG & 4) ? 1 : 0) - ((FASTM & 4) ? 1 : 0) + ((PROBE_REP & 256) ? 2 : 0) - (NFUSE ? 2 : 0);

extern "C" void kernel_launch(void* const* d_in, const int* in_sizes, int n_in, void* d_out, int out_size, void* d_ws, size_t ws_size, hipStream_t stream) {
    static int grid = 0;
    if (grid == 0) {
        if (n_in != 22 || ws_size < WS_RSS + WS_RSS_BYTES) { fprintf(stderr, "kernel_launch: unexpected n_in %d / ws_size %zu (need %zu)\n", n_in, ws_size, (size_t)WS_END); grid = -1; return; }
        int dev = 0, cus = 0, per_cu = 0;
        (void)hipGetDevice(&dev); (void)hipDeviceGetAttribute(&cus, hipDeviceAttributeMultiprocessorCount, dev);
        (void)hipFuncSetAttribute((const void*)fwd_kernel, hipFuncAttributeMaxDynamicSharedMemorySize, LDS_BYTES);
        (void)hipOccupancyMaxActiveBlocksPerMultiprocessor(&per_cu, (const void*)fwd_kernel, NTHR, LDS_BYTES);
        if (per_cu < 1) per_cu = 1;
        grid = cus * per_cu;
        (void)hipGetLastError();
    }
    if (grid < 0) return;
    (void)hipMemsetAsync((char*)d_ws + WS_BAR, 0, 48 * KiB, stream);
    if (NFUSE) (void)hipMemsetAsync((char*)d_ws + WS_RSS, 0, WS_RSS_BYTES, stream);
    Args a{};
    for (int i = 0; i < 22; ++i) a.in[i] = (const float*)d_in[i];
    a.out = (float*)d_out; a.ws = (unsigned char*)d_ws; a.ph_lo = 0; a.ph_hi = N_PHASES;
    void* kargs[] = {&a};
    hipError_t e = hipLaunchCooperativeKernel((const void*)fwd_kernel, dim3(grid), dim3(NTHR), kargs, LDS_BYTES, stream);
    if (e != hipSuccess) fprintf(stderr, "cooperative launch failed: %s (grid %d)\n", hipGetErrorString(e), grid);
}
```

```cpp
#include <hip/hip_runtime.h>
#include <hip/hip_cooperative_groups.h>
#include <cstdio>
#include <cstdint>
namespace cg = cooperative_groups;

typedef unsigned short u16;
typedef short bf16x8 __attribute__((ext_vector_type(8)));
typedef float f32x4 __attribute__((ext_vector_type(4)));
typedef unsigned u32x4 __attribute__((ext_vector_type(4)));
typedef unsigned u32x2 __attribute__((ext_vector_type(2)));
#define DEV __device__ __forceinline__

constexpr int D = 1024, NCTX = 256, NLAT = 16384, R = NCTX + NLAT;
constexpr int FH = 2816, F2 = 5632;
constexpr int EVEN_IN = 1792, ODD_IN = 3104, ODD_PAD = 3328, PMW = 3072;
constexpr int NPC = R / 128;
constexpr int NITEM = 2 * 8 * NPC;
constexpr float EPS = 1e-6f;
constexpr float C2 = 0.125f * 1.4426950408889634f;
constexpr int NWAVES = 8, NTHR = 512;
constexpr int LDS_BYTES = 147456;
#ifndef NFUSE
#define NFUSE 1
#endif
#ifndef FIXEDREF
#define FIXEDREF 1
#endif
#ifndef PREP_DEFER
#define PREP_DEFER 1
#endif
#ifndef KSPLIT
#define KSPLIT 1
#endif
#ifndef PROBE_REP
#define PROBE_REP 0
#endif
#define REPN(bit) for (int rep_ = 0; rep_ < ((PROBE_REP & (bit)) ? 2 : 1); ++rep_)
#ifndef FASTM
#define FASTM 7
#endif
#ifndef FASTA
#define FASTA 1
#endif
#ifndef FASTG
#define FASTG 31
#endif

constexpr size_t KiB = 1024, MiB = 1u << 20;
constexpr size_t WS_MV = 0;
constexpr size_t WS_BAR = 192 * KiB;
constexpr size_t WS_MISC = 256 * KiB;
constexpr size_t WS_GS = 1 * MiB;
constexpr size_t WS_G = 5 * MiB + 256 * KiB;
constexpr size_t WS_W13T = 7 * MiB + 512 * KiB;
constexpr size_t WS_W2T = WS_W13T + 44 * MiB;
constexpr size_t WS_ABIN = WS_W2T + 22 * MiB;
constexpr size_t WS_ABOUT = WS_ABIN + 3 * MiB + 512 * KiB;
constexpr size_t WS_MLIN = WS_ABOUT + 2 * MiB;
constexpr size_t WS_MLOUT = WS_MLIN + 6 * MiB + 512 * KiB;
constexpr size_t WS_SPW = WS_MLOUT + 2 * MiB;
constexpr size_t WS_H = WS_SPW + 256 * KiB;
constexpr size_t WS_XN = WS_H + 65 * MiB;
constexpr size_t WS_BIG = WS_XN + 32 * MiB + 512 * KiB;
constexpr size_t WS_CLOC = WS_BIG + 97 * MiB + 512 * KiB;
constexpr size_t WS_END = WS_CLOC + 65 * MiB;
constexpr size_t WS_RSS = WS_END;
constexpr size_t WS_RSS_BYTES = 6 * (size_t)16640 * 8;
static_assert(WS_RSS + WS_RSS_BYTES <= 352 * MiB, "ws map");

struct Args { const float* in[22]; float* out; unsigned char* ws; int ph_lo, ph_hi; };

DEV float bf2f(u16 v) { return __uint_as_float((unsigned)v << 16); }
DEV u16 f2bf(float f) { unsigned u = __float_as_uint(f); return (u16)((u + 0x7fffu + ((u >> 16) & 1u)) >> 16); }
DEV unsigned pk2(float lo, float hi) { return (unsigned)f2bf(lo) | ((unsigned)f2bf(hi) << 16); }
DEV float silu_f(float x) { return x / (1.f + __expf(-x)); }
DEV float sigmoid_f(float x) { return 1.f / (1.f + __expf(-x)); }
DEV float gelu_tanh(float x) { const float u = 0.7978845608028654f * (x + 0.044715f * x * x * x); return 0.5f * x * (1.f + tanhf(u)); }
DEV float log_sigmoid_f(float x) { return fminf(x, 0.f) - log1pf(__expf(-fabsf(x))); }
DEV float wave_sum(float v) {
#pragma unroll
    for (int o = 1; o < 64; o <<= 1) v += __shfl_xor(v, o);
    return v;
}
#define LDS_FENCE() asm volatile("s_waitcnt lgkmcnt(0)" ::: "memory")
DEV int tid_fresh() { int t = threadIdx.x; asm volatile("" : "+v"(t)); return t; }

struct Ctx {
    const float *x, *c, *ctx, *c_ctx, *mod_w, *mod_b, *norm_g, *ffn_w13, *ffn_w2, *ab_w_in, *ab_gate_norm_g, *ab_spatial_w, *ab_spatial_b,
        *ab_q_norm_g, *ab_k_norm_g, *ab_w_out, *ml_w_in, *ml_conv_w, *ml_gate_b, *ml_out_norm_g, *ml_w_out, *final_norm_g;
    float* out;
    float *ROPE, *MV, *MLOC, *BLAST, *MIN, *NLOC, *BB, *LI, *EE, *RM, *G, *H, *CLOC;
    u16 *W13T, *W2T, *ABIN, *ABOUT, *MLIN, *MLOUT, *SPW, *XN, *BIG, *RAW;
    int tid, lane, wave, gw, NGW, gtid, NT;
    unsigned char* lds;
};

DEV int maprow(int type, int n0) {
    if (type == 1) { if (n0 < FH) return 256 * (n0 / 128) + (n0 % 128); const int j = n0 - FH; return 256 * (j / 128) + 128 + (j % 128); }
    if (type == 2) { const int a = n0 % 256, wc = a / 64, bj = (a % 64) / 32; return (n0 / 256) * 256 + 128 * bj + 32 * wc; }
    return n0;
}
DEV void transpose_item(const float* W, int K, int N, u16* WT, int type, float* scr, int item, int lane) {
    const int nblk = N / 32, kb = item / nblk, nb = item % nblk, k0 = 64 * kb, n0 = 32 * nb;
#pragma unroll 8
    for (int i = 0; i < 32; ++i) { const int kk = 2 * i + (lane >> 5); scr[kk * 33 + (lane & 31)] = W[(size_t)(k0 + kk) * N + n0 + (lane & 31)]; }
    LDS_FENCE();
    const int c = lane & 7, d0 = maprow(type, n0);
#pragma unroll
    for (int j = 0; j < 4; ++j) {
        const int n = (lane >> 3) + 8 * j; const float* s = scr + (8 * c) * 33 + n;
        u32x4 o; o.x = pk2(s[0 * 33], s[1 * 33]); o.y = pk2(s[2 * 33], s[3 * 33]); o.z = pk2(s[4 * 33], s[5 * 33]); o.w = pk2(s[6 * 33], s[7 * 33]);
        *(u32x4*)(WT + (size_t)(d0 + n) * K + k0 + 8 * c) = o;
    }
    LDS_FENCE();
}
DEV void prep_group(const Ctx& X, int grp, int widx, int nworkers) {
    float* scr = (float*)(X.lds) + X.wave * (64 * 33);
    constexpr int I13 = 16 * (F2 / 32), I2 = (FH / 64) * 32, IABI = 16 * (EVEN_IN / 32), ISQ = 16 * 32, IMLI = 16 * (ODD_IN / 32);
    const int fi = grp == 0 ? 0 : grp;
    const int nit = I13 + I2 + (grp == 1 ? IABI + ISQ : (grp == 2 ? IMLI + ISQ : 0));
    for (int it = widx; it < nit; it += nworkers) {
        int r = it;
        if (r < I13) { transpose_item(X.ffn_w13 + (size_t)fi * D * F2, D, F2, X.W13T + (size_t)fi * F2 * D, 1, scr, r, X.lane); continue; } r -= I13;
        if (r < I2) { transpose_item(X.ffn_w2 + (size_t)fi * FH * D, FH, D, X.W2T + (size_t)fi * D * FH, 0, scr, r, X.lane); continue; } r -= I2;
        if (grp == 1) { if (r < IABI) { transpose_item(X.ab_w_in, D, EVEN_IN, X.ABIN, 2, scr, r, X.lane); continue; } r -= IABI; transpose_item(X.ab_w_out, D, D, X.ABOUT, 0, scr, r, X.lane); }
        else { if (r < IMLI) { transpose_item(X.ml_w_in, D, ODD_IN, X.MLIN, 0, scr, r, X.lane); continue; } r -= IMLI; transpose_item(X.ml_w_out, D, D, X.MLOUT, 0, scr, r, X.lane); }
    }
}
DEV void phase_prep(Ctx& X) {
    if (PREP_DEFER) prep_group(X, 0, X.gw, X.NGW);
    else for (int g = 0; g < 4; ++g) prep_group(X, g, X.gw, X.NGW);
    for (int i = X.gtid; i < (ODD_PAD - ODD_IN) * D / 8; i += X.NT) *(u32x4*)(X.MLIN + (size_t)ODD_IN * D + (size_t)i * 8) = (u32x4){0u, 0u, 0u, 0u};
    for (int i = X.gtid; i < 8 * 128 * 128 / 4; i += X.NT) { const f32x4 v = *(const f32x4*)(X.ab_spatial_w + (size_t)i * 4); u32x2 o; o.x = pk2(v.x, v.y); o.y = pk2(v.z, v.w); *(u32x2*)(X.SPW + (size_t)i * 4) = o; }
    for (int i = X.gtid; i < 256 * 16; i += X.NT) { const int pos = i >> 4, k = i & 15; const float ang = (float)pos * powf(10000.f, -(float)(2 * k) / 32.f); X.ROPE[pos * 32 + k] = cosf(ang); X.ROPE[pos * 32 + 16 + k] = sinf(ang); }
    __syncthreads();
    float* sS = (float*)X.lds;
    float* red = sS + 2048;
    for (int i = X.tid; i < 1024; i += NTHR) { sS[i] = silu_f(X.c[i]); sS[1024 + i] = silu_f(X.c_ctx[i]); }
    __syncthreads();
    for (int it = blockIdx.x; it < 2 * 288; it += gridDim.x) {
        const int l = it / 288, cg0 = (it % 288) * 32, col = cg0 + (X.tid & 31), ks = X.tid >> 5;
        const float* w = X.mod_w + (size_t)l * D * 9216 + (size_t)(ks * 64) * 9216 + col;
        float a0 = 0.f, a1 = 0.f;
#pragma unroll 8
        for (int k = 0; k < 64; ++k) { const float wv = w[(size_t)k * 9216]; a0 += sS[ks * 64 + k] * wv; a1 += sS[1024 + ks * 64 + k] * wv; }
        red[(ks * 32 + (X.tid & 31)) * 2] = a0; red[(ks * 32 + (X.tid & 31)) * 2 + 1] = a1;
        __syncthreads();
        if (X.tid < 64) {
            const int cc = X.tid & 31, w2 = X.tid >> 5; float s = 0.f;
            for (int k = 0; k < 16; ++k) s += red[(k * 32 + cc) * 2 + w2];
            X.MV[(size_t)(l * 2 + w2) * 9216 + cg0 + cc] = s + X.mod_b[(size_t)l * 9216 + cg0 + cc];
        }
        __syncthreads();
    }
}

DEV const float* row_src(const Ctx& X, bool from_in, int r) { return from_in ? (r < NCTX ? X.ctx + (size_t)r * D : X.x + (size_t)(r - NCTX) * D) : X.H + (size_t)r * D; }
DEV void phase_norm(Ctx& X, int l, int i, bool from_in, int r_lo, int nks = 0, int r_hi = R) {
    const float* g = X.norm_g + (size_t)(l * 3 + i) * D;
    for (int r = r_lo + X.gw; r < r_hi; r += X.NGW) {
        const f32x4* xr = (const f32x4*)row_src(X, from_in, r) + X.lane;
        const float* mv = X.MV + (size_t)(l * 2 + (r < NCTX ? 1 : 0)) * 9216 + (size_t)(3 * i) * D;
        f32x4 v[4]; float s = 0.f;
#pragma unroll
        for (int j = 0; j < 4; ++j) v[j] = xr[64 * j];
        const bool addp = nks > 0 && r < NCTX;
        if (addp) for (int k = 0; k < nks; ++k) { const f32x4* pr = (const f32x4*)(X.CLOC + ((size_t)k * 256 + r) * D) + X.lane;
#pragma unroll
            for (int j = 0; j < 4; ++j) v[j] = v[j] + pr[64 * j]; }
#pragma unroll
        for (int j = 0; j < 4; ++j) s += (v[j].x * v[j].x + v[j].y * v[j].y) + (v[j].z * v[j].z + v[j].w * v[j].w);
        const float rs = rsqrtf(wave_sum(s) * (1.f / D) + EPS);
        if ((from_in && r < NCTX) || addp) { f32x4* hr = (f32x4*)(X.H + (size_t)r * D) + X.lane;
#pragma unroll
            for (int j = 0; j < 4; ++j) hr[64 * j] = v[j]; }
        u32x2* o = (u32x2*)(X.XN + (size_t)r * D) + X.lane;
#pragma unroll
        for (int j = 0; j < 4; ++j) {
            const int c = 4 * X.lane + 256 * j;
            const f32x4 gg = *(const f32x4*)(g + c), sh = *(const f32x4*)(mv + c), sc = *(const f32x4*)(mv + D + c);
            f32x4 y = v[j] * rs * gg * (sc + 1.f) + sh;
            u32x2 w; w.x = pk2(y.x, y.y); w.y = pk2(y.z, y.w); o[64 * j] = w;
        }
    }
}
DEV void phase_final(Ctx& X) {
    for (int t = X.gw; t < NLAT; t += X.NGW) {
        const f32x4* xr = (const f32x4*)(X.H + (size_t)(NCTX + t) * D) + X.lane;
        f32x4 v[4]; float s = 0.f;
#pragma unroll
        for (int j = 0; j < 4; ++j) { v[j] = xr[64 * j]; s += (v[j].x * v[j].x + v[j].y * v[j].y) + (v[j].z * v[j].z + v[j].w * v[j].w); }
        const float rs = rsqrtf(wave_sum(s) * (1.f / D) + EPS);
        f32x4* o = (f32x4*)(X.out + (size_t)t * D) + X.lane;
#pragma unroll
        for (int j = 0; j < 4; ++j) { const f32x4 gg = *(const f32x4*)(X.final_norm_g + 4 * X.lane + 256 * j); o[64 * j] = v[j] * rs * gg; }
    }
}

template <bool DUAL, class F>
DEV void ngemm(const Ctx& X, const u16* A, int lda, const u16* Bt, int K, int row0, int nrows, int ncols_tile, const F& f) {
    const int nrt = nrows / 32, spu = DUAL ? 4 : 8, nslots = (ncols_tile / 256) * spu, fr = X.lane & 15, fq = X.lane >> 4;
    for (long it = X.gw; it < (long)nrt * nslots; it += X.NGW) {
        const int rt = (int)(it % nrt), sl = (int)(it / nrt), u = sl / spu, s = sl % spu, n0 = u * 256 + 32 * s, r0 = row0 + rt * 32;
        f32x4 acc[2][2], acc2[2][2];
#pragma unroll
        for (int m = 0; m < 2; ++m)
#pragma unroll
            for (int n = 0; n < 2; ++n) { acc[m][n] = (f32x4){0.f, 0.f, 0.f, 0.f}; acc2[m][n] = (f32x4){0.f, 0.f, 0.f, 0.f}; }
        const u16* a0 = A + (size_t)(r0 + fr) * lda + fq * 8;
        const u16* b0 = Bt + (size_t)(n0 + fr) * K + fq * 8;
        for (int k = 0; k < K; k += 32) {
            bf16x8 a[2], b[2], c[2];
            a[0] = *(const bf16x8*)(a0 + k); a[1] = *(const bf16x8*)(a0 + (size_t)16 * lda + k);
            b[0] = *(const bf16x8*)(b0 + k); b[1] = *(const bf16x8*)(b0 + (size_t)16 * K + k);
            if (DUAL) { c[0] = *(const bf16x8*)(b0 + (size_t)128 * K + k); c[1] = *(const bf16x8*)(b0 + (size_t)144 * K + k); }
#pragma unroll
            for (int m = 0; m < 2; ++m)
#pragma unroll
                for (int n = 0; n < 2; ++n) {
                    acc[m][n] = __builtin_amdgcn_mfma_f32_16x16x32_bf16(a[m], b[n], acc[m][n], 0, 0, 0);
                    if (DUAL) acc2[m][n] = __builtin_amdgcn_mfma_f32_16x16x32_bf16(a[m], c[n], acc2[m][n], 0, 0, 0);
                }
        }
#pragma unroll
        for (int m = 0; m < 2; ++m)
#pragma unroll
            for (int n = 0; n < 2; ++n)
#pragma unroll
                for (int j = 0; j < 4; ++j) f(r0 + 16 * m + 4 * fq + j, n0 + 16 * n + fr, acc[m][n][j], acc2[m][n][j]);
    }
}
struct FSwiglu { u16* HID; DEV void operator()(int r, int p, float g, float u) const { const int col = 128 * (p / 256) + (p % 256); HID[(size_t)r * FH + col] = f2bf(silu_f(g) * u); } };
struct FResid { const Ctx* X; bool from_in; const float* mvl; const float* mvc; float mul;
    DEV void operator()(int r, int c, float v, float) const { const float b = row_src(*X, from_in, r)[c]; const float m = (r < NCTX ? mvc : mvl)[c]; X->H[(size_t)r * D + c] = b + mul * m * v; } };
struct FRawAB { u16* RAW; DEV void operator()(int r, int p, float v, float) const { const int q = p % 256, bj = q / 128, wc = (q % 128) / 32, x = q % 32; RAW[(size_t)r * EVEN_IN + (p / 256) * 256 + 64 * wc + 32 * bj + x] = f2bf(v); } };
struct FML { u16* PM; float* G; const float* gb; DEV void operator()(int r, int c, float v, float) const { if (c < PMW) PM[(size_t)r * PMW + c] = f2bf(v); else if (c < ODD_IN) G[(size_t)r * 32 + (c - PMW)] = v + gb[c - PMW]; } };

DEV void phase_abpost(Ctx& X) {
    u16* P0 = X.BIG;
    for (int it = X.gtid; it < R * 28; it += X.NT) {
        const int r = it / 28, grp = it % 28, c0 = grp * 64;
        const u16* src = X.RAW + (size_t)r * EVEN_IN + c0; u16* dst = P0 + (size_t)r * EVEN_IN + c0;
        if (grp < 8) { for (int d = 0; d < 64; ++d) dst[d] = f2bf(gelu_tanh(bf2f(src[d]))); continue; }
        if (grp >= 26) { for (int d = 0; d < 64; ++d) dst[d] = src[d]; continue; }
        float ss = 0.f;
        if (grp < 16) { for (int d = 0; d < 64; ++d) { const float v = gelu_tanh(bf2f(src[d])); ss += v * v; } const float rs = rsqrtf(ss * (1.f / 64) + EPS);
            for (int d = 0; d < 64; ++d) dst[d] = f2bf(gelu_tanh(bf2f(src[d])) * rs * X.ab_gate_norm_g[c0 - 512 + d]); continue; }
        for (int d = 0; d < 64; ++d) { const float v = bf2f(src[d]); ss += v * v; }
        const float rs = rsqrtf(ss * (1.f / 64) + EPS); const bool isq = grp < 24; const float* g = isq ? X.ab_q_norm_g : X.ab_k_norm_g; const float osc = isq ? C2 : 1.f;
        if (r < NCTX) { for (int d = 0; d < 64; ++d) dst[d] = f2bf(bf2f(src[d]) * rs * g[d] * osc); continue; }
        const int t = r - NCTX; const float pr = (float)(t / 64), pc = (float)(t % 64);
        for (int half = 0; half < 2; ++half) for (int i = 0; i < 16; ++i) {
            const float invf = __powf(10000.f, -(float)(2 * i) / 32.f), ang = (half ? pc : pr) * invf, cs = cosf(ang), sn = sinf(ang);
            const int d1 = half * 32 + i, d2 = d1 + 16; const float x1 = bf2f(src[d1]) * rs * g[d1], x2 = bf2f(src[d2]) * rs * g[d2];
            dst[d1] = f2bf((x1 * cs - x2 * sn) * osc); dst[d2] = f2bf((x2 * cs + x1 * sn) * osc);
        }
    }
}
DEV void phase_sgu_naive(Ctx& X) {
    const u16* P0 = X.BIG; u16* CAT = X.XN;
    for (int it = X.gtid; it < R * 512; it += X.NT) {
        const int r = it / 512, col = it % 512, ch = r / 128, t = r % 128, g = col / 64;
        const float* w = X.ab_spatial_w + (size_t)(g * 128 + t) * 128; float s = X.ab_spatial_b[g * 128 + t];
        for (int sp = 0; sp < 128; ++sp) s += w[sp] * bf2f(P0[(size_t)(ch * 128 + sp) * EVEN_IN + 512 + col]);
        CAT[(size_t)r * D + col] = f2bf(bf2f(P0[(size_t)r * EVEN_IN + col]) * s);
    }
}
DEV void phase_attn_naive(Ctx& X) {
    const u16* P0 = X.BIG; u16* CAT = X.XN;
    for (int it = X.gtid; it < R * 8; it += X.NT) {
        const int h = __builtin_amdgcn_readfirstlane(it / R), r = it % R, kvh = h / 4;
        const int nkeys = __builtin_amdgcn_readfirstlane(r < NCTX ? NCTX : R);
        float q[64], acc[64];
        for (int d = 0; d < 64; ++d) { q[d] = bf2f(P0[(size_t)r * EVEN_IN + 1024 + h * 64 + d]); acc[d] = 0.f; }
        float m = -1e30f, l = 0.f;
        for (int key = 0; key < nkeys; ++key) {
            const u16* kp = P0 + (size_t)key * EVEN_IN + 1536 + kvh * 64; const u16* vp = kp + 128;
            float s = 0.f;
#pragma unroll
            for (int d = 0; d < 64; ++d) s += q[d] * bf2f(kp[d]);
            if (s > m) { const float f = exp2f(m - s); l *= f;
#pragma unroll
                for (int d = 0; d < 64; ++d) acc[d] *= f;
                m = s; }
            const float p = exp2f(s - m); l += p;
#pragma unroll
            for (int d = 0; d < 64; ++d) acc[d] += p * bf2f(vp[d]);
        }
        const float il = 1.f / l;
        for (int d = 0; d < 64; ++d) CAT[(size_t)r * D + 512 + h * 64 + d] = f2bf(acc[d] * il);
    }
}

DEV int item_of(int d, int h, int pc) { return (d * 8 + h) * NPC + pc; }
DEV void phase_x1(Ctx& X) {
    const u16* PM = X.BIG; u16* QKC = X.XN;
    for (int it = X.gtid; it < R * 128; it += X.NT) {
        const int r = it / 128, c0 = (it % 128) * 8;
        const bool hp = (r != 0 && r != NCTX), hn = (r != NCTX - 1 && r != R - 1);
        const u16* p1 = PM + (size_t)r * PMW + c0;
        const bf16x8 z = (bf16x8){0, 0, 0, 0, 0, 0, 0, 0};
        const bf16x8 v1 = *(const bf16x8*)p1, v0 = hp ? *(const bf16x8*)(p1 - PMW) : z, v2 = hn ? *(const bf16x8*)(p1 + PMW) : z;
        const float sc = c0 < 512 ? 0.125f : 1.f; float y[8];
#pragma unroll
        for (int j = 0; j < 8; ++j) { const float a = X.ml_conv_w[c0 + j] * bf2f((u16)v0[j]) + X.ml_conv_w[1024 + c0 + j] * bf2f((u16)v1[j]) + X.ml_conv_w[2048 + c0 + j] * bf2f((u16)v2[j]); y[j] = silu_f(a) * sc; }
        u32x4 o; o.x = pk2(y[0], y[1]); o.y = pk2(y[2], y[3]); o.z = pk2(y[4], y[5]); o.w = pk2(y[6], y[7]);
        *(u32x4*)(QKC + (size_t)r * D + c0) = o;
    }
    for (int it = X.gw; it < NITEM; it += X.NGW) {
        const int d = it / (8 * NPC), h = (it / NPC) % 8, pc = it % NPC, lane = X.lane;
        const int pf = d == 0 ? 2 * lane : 2 * lane + 1, ps = d == 0 ? 2 * lane + 1 : 2 * lane;
        const float* g0 = X.G + (size_t)(pc * 128) * 32;
        const float lif = g0[pf * 32 + (2 * d) * 8 + h], lis = g0[ps * 32 + (2 * d) * 8 + h];
        const float lff = log_sigmoid_f(g0[pf * 32 + (2 * d + 1) * 8 + h]), lfs = log_sigmoid_f(g0[ps * 32 + (2 * d + 1) * 8 + h]);
        float P = lff + lfs;
#pragma unroll
        for (int o = 1; o < 64; o <<= 1) { const float t = d == 0 ? __shfl_up(P, o) : __shfl_down(P, o); const bool ok = d == 0 ? (lane >= o) : (lane + o < 64); if (ok) P += t; }
        const float total = __shfl(P, d == 0 ? 63 : 0);
        const float Cs = P, Cf = P - lfs;
        const float xf = lif - Cf, xs = lis - Cs;
        float M = fmaxf(xf, xs);
#pragma unroll
        for (int o = 1; o < 64; o <<= 1) { const float t = d == 0 ? __shfl_up(M, o) : __shfl_down(M, o); const bool ok = d == 0 ? (lane >= o) : (lane + o < 64); if (ok) M = fmaxf(M, t); }
        float ex = d == 0 ? __shfl_up(M, 1) : __shfl_down(M, 1); if (d == 0 ? lane == 0 : lane == 63) ex = -INFINITY;
        const float rmf = fmaxf(ex, xf), rms = fmaxf(rmf, xs);
        const float wf = total - Cf + lif, ws = total - Cs + lis;
        float mw = fmaxf(wf, ws);
#pragma unroll
        for (int o = 1; o < 64; o <<= 1) mw = fmaxf(mw, __shfl_xor(mw, o));
        float* bb = X.BB + (size_t)it * 128; float* li = X.LI + (size_t)it * 128; float* ee = X.EE + (size_t)it * 128; float* rm = X.RM + (size_t)it * 128;
        bb[pf] = Cf; bb[ps] = Cs; li[pf] = lif; li[ps] = lis; ee[pf] = __expf(wf - mw); ee[ps] = __expf(ws - mw); rm[pf] = rmf; rm[ps] = rms;
        if (lane == 0) { X.MLOC[it] = mw; X.BLAST[it] = total; }
    }
}
DEV void phase_m1_naive(Ctx& X) {
    const u16* PM = X.BIG; const u16* QKC = X.XN;
    for (long it = X.gtid; it < (long)NITEM * 8192; it += X.NT) {
        const int item = (int)(it / 8192), e = (int)(it % 8192), vv = e / 64, kk = e % 64, h = (item / NPC) % 8, pc = item % NPC;
        const float* ee = X.EE + (size_t)item * 128; float s = 0.f, sn = 0.f;
        for (int p = 0; p < 128; ++p) { const size_t row = (size_t)pc * 128 + p; const float kv = bf2f(QKC[row * D + 512 + h * 64 + kk]) * ee[p]; sn += kv; s += kv * bf2f(PM[row * PMW + 1024 + h * 128 + vv]); }
        X.CLOC[(size_t)item * 8192 + e] = s; if (vv == 0) X.NLOC[(size_t)item * 64 + kk] = sn;
    }
}
DEV int scan_pc(int d, int n) { return d == 0 ? n : (n == 0 ? 1 : (n == 1 ? 0 : 131 - n)); }
DEV void phase_m2(Ctx& X) {
    for (int it = X.gtid; it < 16 * 8192; it += X.NT) {
        const int dh = it >> 13, e = it & 8191; const bool hasn = e < 64;
        float* cb = X.CLOC + e; float* nb = X.NLOC + (hasn ? e : 0);
        float C = 0.f, Nn = 0.f, m = 0.f;
        float cl[13], nl[13], bl[13], ml[13]; int itm[13];
#define M2_LOAD(n0) _Pragma("unroll") for (int i = 0; i < 13; ++i) { itm[i] = dh * NPC + scan_pc(dh >> 3, (n0) + i); cl[i] = cb[(size_t)itm[i] * 8192]; nl[i] = hasn ? nb[(size_t)itm[i] * 64] : 0.f; bl[i] = X.BLAST[itm[i]]; ml[i] = X.MLOC[itm[i]]; }
        M2_LOAD(0)
#pragma unroll 1
        for (int n0 = 0; n0 < NPC; n0 += 13) {
            float ccl[13], cnl[13], cbl[13], cml[13]; int citm[13];
#pragma unroll
            for (int i = 0; i < 13; ++i) { ccl[i] = cl[i]; cnl[i] = nl[i]; cbl[i] = bl[i]; cml[i] = ml[i]; citm[i] = itm[i]; }
            if (n0 + 13 < NPC) { M2_LOAD(n0 + 13) }
#pragma unroll
            for (int i = 0; i < 13; ++i) {
                const float mn = fmaxf(cbl[i] + m, cml[i]), a = __expf(cbl[i] + m - mn), g = __expf(cml[i] - mn);
                cb[(size_t)citm[i] * 8192] = C; if (hasn) nb[(size_t)citm[i] * 64] = Nn; if (e == 0) X.MIN[citm[i]] = m;
                C = a * C + g * ccl[i]; Nn = a * Nn + g * cnl[i]; m = mn;
            }
        }
#undef M2_LOAD
    }
}
DEV void phase_m3_naive(Ctx& X) {
    u16* PM = X.BIG; const u16* QKC = X.XN;
    for (int it = X.gtid; it < 8 * 4 * NLAT; it += X.NT) {
        const int t = it % NLAT, hv = __builtin_amdgcn_readfirstlane(it / NLAT), h = hv / 4, vq = hv % 4, r = NCTX + t;
        const int pc = __builtin_amdgcn_readfirstlane(r / 128), j = r % 128;
        float q[64]; for (int k = 0; k < 64; ++k) q[k] = bf2f(QKC[(size_t)r * D + h * 64 + k]);
        float hacc[32]; for (int v = 0; v < 32; ++v) hacc[v] = 0.f;
        for (int d = 0; d < 2; ++d) {
            const int item = item_of(d, h, pc);
            const float* bb = X.BB + (size_t)item * 128; const float* li = X.LI + (size_t)item * 128;
            const float Bj = bb[j], m_in = X.MIN[item], mrow = Bj + fmaxf(m_in, X.RM[(size_t)item * 128 + j]), a = __expf(Bj + m_in - mrow);
            float num[32], den = 0.f;
            const float* cin = X.CLOC + (size_t)item * 8192 + (size_t)(vq * 32) * 64; const float* nin = X.NLOC + (size_t)item * 64;
            for (int k = 0; k < 64; ++k) den += nin[k] * q[k];
            den *= a;
            for (int v = 0; v < 32; ++v) { float s = 0.f; for (int k = 0; k < 64; ++k) s += cin[v * 64 + k] * q[k]; num[v] = a * s; }
            for (int s = 0; s < 128; ++s) {
                const bool valid = d == 0 ? (s <= j) : (s >= j);
                const size_t row = (size_t)pc * 128 + s; const u16* kp = QKC + row * D + 512 + h * 64; const u16* vp = PM + row * PMW + 1024 + h * 128 + vq * 32;
                float sc = 0.f;
#pragma unroll
                for (int k = 0; k < 64; ++k) sc += q[k] * bf2f(kp[k]);
                const float w = valid ? __expf(Bj - bb[s] + li[s] - mrow) : 0.f; sc *= w; den += sc;
#pragma unroll
                for (int v = 0; v < 32; ++v) num[v] += sc * bf2f(vp[v]);
            }
            const float inv = 1.f / fmaxf(fabsf(den), __expf(-mrow));
            for (int v = 0; v < 32; ++v) hacc[v] += num[v] * inv;
        }
        for (int v = 0; v < 32; ++v) PM[(size_t)r * PMW + h * 128 + vq * 32 + v] = f2bf(hacc[v]);
    }
}
DEV void phase_m3post(Ctx& X) {
    u16* PM = X.BIG;
    for (int it = X.gtid; it < 8 * NLAT; it += X.NT) {
        const int t = it % NLAT, h = it / NLAT; u16* p = PM + (size_t)(NCTX + t) * PMW + h * 128; const u16* o = p + 2048;
        float ss = 0.f; for (int v = 0; v < 128; ++v) { const float x = bf2f(p[v]); ss += x * x; }
        const float rs = rsqrtf(ss * (1.f / 128) + EPS);
        for (int v = 0; v < 128; ++v) p[v] = f2bf(bf2f(p[v]) * rs * X.ml_out_norm_g[h * 128 + v] * sigmoid_f(bf2f(o[v])));
    }
}

namespace pg8 {
#define PG8_LAS __attribute__((address_space(3)))
typedef unsigned short bf16_t;
typedef short bf16x8 __attribute__((ext_vector_type(8)));
typedef float f32x4 __attribute__((ext_vector_type(4)));
typedef unsigned u32x4 __attribute__((ext_vector_type(4)));
constexpr int BM = 256, BK = 64, HALF = 128, HTB = HALF * BK * 2  , STAGE_BYTES = 8 * HTB, NXCD = 8, WGM = 4;

__host__ __device__ __forceinline__ int lds_byte(int r, int c) { const int st = (r >> 4) * 2 + (c >> 5), rr = r & 15, cc = c & 31, ob = rr * 64 + cc * 2; return st * 1024 + (ob ^ (((ob >> 9) & 1) << 5)); }
__host__ __device__ __forceinline__ void stage_rc(int b, int& R, int& C) { const int st = b / 1024, sb = b % 1024, swz = sb ^ (((sb >> 9) & 1) << 5); R = (st >> 1) * 16 + swz / 64; C = (st & 1) * 32 + (swz % 64) / 2; }
__host__ __device__ __forceinline__ int perm32(int rho) { const int n = rho >> 4, i = rho & 15; return 8 * (i >> 2) + 4 * n + (i & 3); }

struct Unit { int pm, pn, ko; };
struct Gemm { const bf16_t* A; int lda; const bf16_t* Bt; int ldb; int M, N, K; };
struct Order {
    int nM, nN, nwg, G, c, pm0;
    __device__ void init(int M, int N, int G_, int c_, int pm0_) { nM = M / BM; nN = N / BM; nwg = nM * nN; G = G_; c = c_; pm0 = pm0_; }
    __device__ bool next(int i, Unit& u) const {
        const long L = (long)i * G + c; if (L >= nwg) return false;
        int wgid = (int)L; { const int q = nwg / NXCD, r = nwg % NXCD, xcd = wgid % NXCD, off = wgid / NXCD; wgid = (xcd < r ? xcd * (q + 1) : r * (q + 1) + (xcd - r) * q) + off; }
        const int nig = WGM * nN, gid = wgid / nig, fm = gid * WGM, gsz = (nM - fm) < WGM ? (nM - fm) : WGM;
        u.pm = pm0 + fm + ((wgid % nig) % gsz); u.pn = (wgid % nig) / gsz; u.ko = 0; return true;
    }
    __device__ __forceinline__ void a_ready(const Unit&) const {}
    __device__ __forceinline__ void done(const Unit&) const {}
};
struct OrderKS {
    int nN, nwg, G, c, kc;
    __device__ void init(int N, int S, int kc_, int G_, int c_) { nN = N / BM; nwg = nN * S; G = G_; c = c_; kc = kc_; }
    __device__ bool next(int i, Unit& u) const { const long L = (long)i * G + c; if (L >= nwg) return false; u.pm = 0; u.pn = (int)L % nN; u.ko = ((int)L / nN) * kc; return true; }
    __device__ __forceinline__ void a_ready(const Unit&) const {}
    __device__ __forceinline__ void done(const Unit&) const {}
};

template <class Epi, class Sched, bool ALIGN_EPI = false, bool SP2 = false>
__device__ __forceinline__ void gemm_phase(PG8_LAS unsigned char* lds, const Gemm g, const Sched& S, const Epi& E) {
    const int tid = tid_fresh(), wid = __builtin_amdgcn_readfirstlane(tid >> 6), lane = tid & 63, wr = wid >> 2, wc = wid & 3, fr = lane & 15, fq = lane >> 4;
    const int K = g.K, nt = K / BK;
    unsigned voffA[2], voffB[2];
#pragma unroll
    for (int i = 0; i < 2; ++i) { int R, C; stage_rc(tid * 16 + i * 8192, R, C); const int Rb = Epi::PERM ? ((R & ~31) + perm32(R & 31)) : R;
        voffA[i] = (unsigned)(R * g.lda + C) * 2u; voffB[i] = (unsigned)(Rb * g.ldb + C) * 2u; }
    const size_t kstep = (size_t)(BK * 2);
    const size_t hstepA = (size_t)HALF * g.lda * 2, hstepB = (size_t)HALF * g.ldb * 2;
    const size_t tstepA = 2 * hstepA, tstepB = 2 * hstepB;
    const unsigned ldsw = (unsigned)wid * 1024u;
    const int aoff = lds_byte(wr * 64 + fr, fq * 8), boff = lds_byte(wc * 32 + fr, fq * 8);
#define PG8_SA(b, h) (((b) * 2 + (h)) * HTB)
#define PG8_SB(b, h) ((4 + (b) * 2 + (h)) * HTB)
#define PG8_STAGE(bufoff, gbase, voff) do { _Pragma("unroll") for (int _i = 0; _i < 2; ++_i) \
        __builtin_amdgcn_global_load_lds((const unsigned*)((const char*)(gbase) + (voff)[_i]), (PG8_LAS unsigned*)(lds + (bufoff) + ldsw + _i * 8192), 16, 0, 0); } while (0)
#define PG8_LDA(dst, b, h) do { _Pragma("unroll") for (int m = 0; m < 4; ++m) _Pragma("unroll") for (int k = 0; k < 2; ++k) dst[m][k] = *(const PG8_LAS bf16x8*)(lds + PG8_SA(b, h) + aoff + m * 2048 + k * 1024); } while (0)
#define PG8_LDB(dst, b, h) do { _Pragma("unroll") for (int n = 0; n < 2; ++n) _Pragma("unroll") for (int k = 0; k < 2; ++k) dst[n][k] = *(const PG8_LAS bf16x8*)(lds + PG8_SB(b, h) + boff + n * 2048 + k * 1024); } while (0)
#define PG8_MMA(ai, bj, At, Bt) do { __builtin_amdgcn_s_setprio(1); _Pragma("unroll") for (int m = 0; m < 4; ++m) _Pragma("unroll") for (int n = 0; n < 2; ++n) _Pragma("unroll") for (int k = 0; k < 2; ++k) \
        acc[ai][bj][m][n] = __builtin_amdgcn_mfma_f32_16x16x32_bf16(Bt[n][k], At[m][k], acc[ai][bj][m][n], 0, 0, 0); __builtin_amdgcn_s_setprio(0); } while (0)
#define PG8_WAIT_V(n) asm volatile("s_waitcnt vmcnt(" #n ")" ::: "memory")
#define PG8_WAIT_L(n) asm volatile("s_waitcnt lgkmcnt(" #n ")" ::: "memory")
#define PG8_BAR __builtin_amdgcn_s_barrier()
#define PG8_SCHED __builtin_amdgcn_sched_barrier(0)
    Unit cur, nxt; int ui = 0;
    if (!S.next(0, cur)) return;
    f32x4 acc[2][2][4][2];
#pragma unroll
    for (int a = 0; a < 2; ++a)
#pragma unroll
        for (int b = 0; b < 2; ++b)
#pragma unroll
            for (int m = 0; m < 4; ++m)
#pragma unroll
                for (int n = 0; n < 2; ++n) acc[a][b][m][n] = (f32x4){0.f, 0.f, 0.f, 0.f};
    bf16x8 At[4][2], B0[2][2], B1[2][2];
    const char* cA = (const char*)g.A + (size_t)cur.pm * tstepA + (size_t)cur.ko * 2; const char* cB = (const char*)g.Bt + (size_t)cur.pn * tstepB + (size_t)cur.ko * 2;
    S.a_ready(cur);
    if constexpr (SP2) {
        PG8_STAGE(PG8_SB(0, 0), cB, voffB); PG8_STAGE(PG8_SB(0, 1), cB + hstepB, voffB); PG8_STAGE(PG8_SA(0, 0), cA, voffA); PG8_STAGE(PG8_SA(0, 1), cA + hstepA, voffA);
        if (wr == 1) PG8_BAR;
        PG8_WAIT_V(2); PG8_BAR;
        PG8_STAGE(PG8_SB(1, 0), cB + kstep, voffB); PG8_STAGE(PG8_SA(1, 0), cA + kstep, voffA); PG8_STAGE(PG8_SB(1, 1), cB + hstepB + kstep, voffB);
        PG8_WAIT_V(6); PG8_BAR;
    } else {
        PG8_STAGE(PG8_SB(0, 0), cB, voffB); PG8_STAGE(PG8_SA(0, 0), cA, voffA); PG8_STAGE(PG8_SB(0, 1), cB + hstepB, voffB); PG8_STAGE(PG8_SA(0, 1), cA + hstepA, voffA);
        if (wr == 1) PG8_BAR;
        PG8_WAIT_V(4); PG8_BAR;
        PG8_STAGE(PG8_SB(1, 0), cB + kstep, voffB); PG8_STAGE(PG8_SA(1, 0), cA + kstep, voffA); PG8_STAGE(PG8_SB(1, 1), cB + hstepB + kstep, voffB);
        PG8_WAIT_V(6); PG8_BAR;
    }
    for (;;) {
        const bool has_next = S.next(ui + 1, nxt);
        const char* nA = has_next ? (const char*)g.A + (size_t)nxt.pm * tstepA + (size_t)nxt.ko * 2 : cA; const char* nB = has_next ? (const char*)g.Bt + (size_t)nxt.pn * tstepB + (size_t)nxt.ko * 2 : cB;
        for (int t = 0; t < nt; t += 2) {
            const bool last = (t == nt - 2);
            const char* a1 = cA + (size_t)(t + 1) * kstep;
            const char* a2 = last ? nA : cA + (size_t)(t + 2) * kstep; const char* b2 = last ? nB : cB + (size_t)(t + 2) * kstep;
            const char* a3 = a2 + kstep; const char* b3 = b2 + kstep;
            if (last && has_next) S.a_ready(nxt);
            if constexpr (SP2) {
            PG8_LDB(B0, 0, 0); PG8_LDB(B1, 0, 1); PG8_SCHED; PG8_LDA(At, 0, 0); PG8_STAGE(PG8_SA(1, 1), a1 + hstepA, voffA);
            PG8_WAIT_V(8); PG8_WAIT_L(0); PG8_BAR; PG8_MMA(0, 0, At, B0); PG8_MMA(0, 1, At, B1); PG8_BAR; PG8_SCHED;
            PG8_LDA(At, 0, 1); PG8_STAGE(PG8_SB(0, 0), b2, voffB); PG8_STAGE(PG8_SB(0, 1), b2 + hstepB, voffB); PG8_STAGE(PG8_SA(0, 0), a2, voffA);
            PG8_WAIT_V(8); PG8_WAIT_L(0); PG8_BAR; PG8_MMA(1, 0, At, B0); PG8_MMA(1, 1, At, B1); PG8_BAR; PG8_SCHED;
            PG8_LDB(B0, 1, 0); PG8_LDB(B1, 1, 1); PG8_SCHED; PG8_LDA(At, 1, 0); PG8_STAGE(PG8_SA(0, 1), a2 + hstepA, voffA);
            PG8_WAIT_V(8); PG8_WAIT_L(0); PG8_BAR; PG8_MMA(0, 0, At, B0); PG8_MMA(0, 1, At, B1); PG8_BAR; PG8_SCHED;
            PG8_LDA(At, 1, 1); PG8_STAGE(PG8_SB(1, 0), b3, voffB); PG8_STAGE(PG8_SB(1, 1), b3 + hstepB, voffB); PG8_STAGE(PG8_SA(1, 0), a3, voffA);
            PG8_WAIT_V(8); PG8_WAIT_L(0); PG8_BAR; PG8_MMA(1, 0, At, B0); PG8_MMA(1, 1, At, B1); PG8_BAR; PG8_SCHED;
            } else {
            PG8_LDB(B0, 0, 0); PG8_SCHED; PG8_LDA(At, 0, 0); PG8_STAGE(PG8_SA(1, 1), a1 + hstepA, voffA);
            PG8_WAIT_L(8); PG8_BAR; PG8_WAIT_L(0); PG8_MMA(0, 0, At, B0); PG8_BAR; PG8_SCHED;
            PG8_LDB(B1, 0, 1); PG8_STAGE(PG8_SB(0, 0), b2, voffB);
            PG8_BAR; PG8_WAIT_L(0); PG8_MMA(0, 1, At, B1); PG8_BAR;
            PG8_LDA(At, 0, 1); PG8_STAGE(PG8_SA(0, 0), a2, voffA);
            PG8_BAR; PG8_WAIT_L(0); PG8_MMA(1, 0, At, B0); PG8_BAR; PG8_SCHED;
            PG8_STAGE(PG8_SB(0, 1), b2 + hstepB, voffB);
            PG8_WAIT_V(6); PG8_BAR; PG8_MMA(1, 1, At, B1); PG8_BAR;
            PG8_LDB(B0, 1, 0); PG8_SCHED; PG8_LDA(At, 1, 0); PG8_STAGE(PG8_SA(0, 1), a2 + hstepA, voffA);
            PG8_WAIT_L(8); PG8_BAR; PG8_WAIT_L(0); PG8_MMA(0, 0, At, B0); PG8_BAR; PG8_SCHED;
            PG8_LDB(B1, 1, 1); PG8_STAGE(PG8_SB(1, 0), b3, voffB);
            PG8_BAR; PG8_WAIT_L(0); PG8_MMA(0, 1, At, B1); PG8_BAR;
            PG8_LDA(At, 1, 1); PG8_STAGE(PG8_SA(1, 0), a3, voffA);
            PG8_BAR; PG8_WAIT_L(0); PG8_MMA(1, 0, At, B0); PG8_BAR; PG8_SCHED;
            PG8_STAGE(PG8_SB(1, 1), b3 + hstepB, voffB);
            PG8_WAIT_V(6); PG8_BAR; PG8_MMA(1, 1, At, B1); PG8_BAR;
            }
        }
        if constexpr (ALIGN_EPI) { if (wr == 0) PG8_BAR; }
        if constexpr (!Epi::AFTER_DRAIN) { E(acc, cur, wr, wc, fr, fq); S.done(cur); }
        if (!has_next) break;
#pragma unroll
        for (int a = 0; a < 2; ++a)
#pragma unroll
            for (int b = 0; b < 2; ++b)
#pragma unroll
                for (int m = 0; m < 4; ++m)
#pragma unroll
                    for (int n = 0; n < 2; ++n) acc[a][b][m][n] = (f32x4){0.f, 0.f, 0.f, 0.f};
        cur = nxt; cA = nA; cB = nB; ++ui;
        if constexpr (ALIGN_EPI) { if (wr == 1) PG8_BAR; }
    }
    PG8_WAIT_V(0);
    if constexpr (!ALIGN_EPI) { if (wr == 0) PG8_BAR; }
    PG8_BAR;
    if constexpr (Epi::AFTER_DRAIN) { E.fused(acc, cur, wr, wc, fr, fq, lds, wid, lane); S.done(cur); }
#undef PG8_SA
#undef PG8_SB
#undef PG8_STAGE
#undef PG8_LDA
#undef PG8_LDB
#undef PG8_MMA
#undef PG8_WAIT_V
#undef PG8_WAIT_L
#undef PG8_BAR
#undef PG8_SCHED
}
}


DEV float fast_silu(float g) { return g * __builtin_amdgcn_rcpf(1.f + __expf(-g)); }
DEV float fast_gelu(float x) { const float u = 0.7978845608028654f * (x + 0.044715f * x * x * x); const float e = __expf(2.f * u); return x * (1.f - __builtin_amdgcn_rcpf(e + 1.f)); }
typedef pg8::f32x4 pf4;
struct EpiSwiGLU { static constexpr bool PERM = true, AFTER_DRAIN = false; u16* HID;
    DEV void operator()(const pf4 (&acc)[2][2][4][2], const pg8::Unit& u, int wr, int wc, int fr_, int fq_) const {
        int fr = fr_, fq = fq_; asm volatile("" : "+v"(fr), "+v"(fq));
        const int row0 = u.pm * 256 + wr * 64 + fr, col0 = u.pn * 128 + wc * 32 + 8 * fq;
#pragma unroll
        for (int ai = 0; ai < 2; ++ai)
#pragma unroll
            for (int m = 0; m < 4; ++m) {
                const pf4 g0 = acc[ai][0][m][0], g1 = acc[ai][0][m][1], u0 = acc[ai][1][m][0], u1 = acc[ai][1][m][1];
                u32x4 w; w.x = pk2(fast_silu(g0[0]) * u0[0], fast_silu(g0[1]) * u0[1]); w.y = pk2(fast_silu(g0[2]) * u0[2], fast_silu(g0[3]) * u0[3]);
                w.z = pk2(fast_silu(g1[0]) * u1[0], fast_silu(g1[1]) * u1[1]); w.w = pk2(fast_silu(g1[2]) * u1[2], fast_silu(g1[3]) * u1[3]);
                *(u32x4*)(HID + (size_t)(row0 + ai * 128 + m * 16) * FH + col0) = w;
            }
    } };
struct EpiResid { static constexpr bool PERM = false, AFTER_DRAIN = false; const float* bctx; const float* blat; float* H; const float* mvl; const float* mvc; float mul;
    DEV void operator()(const pf4 (&acc)[2][2][4][2], const pg8::Unit& u, int wr, int wc, int fr_, int fq_) const {
        int fr = fr_, fq = fq_; asm volatile("" : "+v"(fr), "+v"(fq));
        const int row0 = u.pm * 256 + wr * 64 + fr, col0 = u.pn * 256 + wc * 32 + 4 * fq;
        const float* mv = u.pm == 0 ? mvc : mvl;
        pf4 mm[2][2];
#pragma unroll
        for (int bj = 0; bj < 2; ++bj)
#pragma unroll
            for (int n = 0; n < 2; ++n) mm[bj][n] = *(const pf4*)(mv + col0 + bj * 128 + n * 16) * mul;
#pragma unroll
        for (int ai = 0; ai < 2; ++ai)
#pragma unroll
            for (int m = 0; m < 4; ++m) {
                const int r = row0 + ai * 128 + m * 16;
                const float* bp = (r < NCTX ? bctx + (size_t)r * D : blat + (size_t)(r - NCTX) * D) + col0; float* hp = H + (size_t)r * D + col0;
#pragma unroll
                for (int bj = 0; bj < 2; ++bj)
#pragma unroll
                    for (int n = 0; n < 2; ++n) { const pf4 b = *(const pf4*)(bp + bj * 128 + n * 16); *(pf4*)(hp + bj * 128 + n * 16) = b + mm[bj][n] * acc[ai][bj][m][n]; }
            }
    } };
template <int mode, int SITE, int MVOFF, int SHOFF, int NGOFF, bool FROM_IN, int MUL2> struct EpiResidNorm { static constexpr bool PERM = false, AFTER_DRAIN = true;
    unsigned char* wsb; const float* ngbase; const float* xin; float* out;
    DEV void fused(pf4 (&acc)[2][2][4][2], const pg8::Unit& u, int wr, int wc, int fr_, int fq_, PG8_LAS unsigned char* lds, int wid, int lane) const {
        int fr = fr_, fq = fq_; asm volatile("" : "+v"(fr), "+v"(fq));
        PG8_LAS float* P = (PG8_LAS float*)lds; PG8_LAS float* S = (PG8_LAS float*)(lds + 8192);
        float* H = (float*)(wsb + WS_H); const float* blat = FROM_IN ? xin : H + (size_t)NCTX * D; const float* mvl = (const float*)(wsb + WS_MV) + MVOFF; const float* shv = (const float*)(wsb + WS_MV) + SHOFF;
        const float* ng = ngbase + NGOFF; u16* XN = (u16*)(wsb + WS_XN); unsigned long long* rss = (unsigned long long*)(wsb + WS_RSS) + (size_t)SITE * R; unsigned* cnt = (unsigned*)(wsb + WS_BAR + 16 * KiB) + SITE * 65 * 16; const float mul = 0.5f * MUL2;
        const int rl0 = wr * 64 + fr, col0 = u.pn * 256 + wc * 32 + 4 * fq;
        {
            pf4 mm[2][2];
#pragma unroll
            for (int bj = 0; bj < 2; ++bj)
#pragma unroll
                for (int n = 0; n < 2; ++n) mm[bj][n] = *(const pf4*)(mvl + col0 + bj * 128 + n * 16) * mul;
#pragma unroll
            for (int ai = 0; ai < 2; ++ai)
#pragma unroll
                for (int m = 0; m < 4; ++m) {
                    const int rl = rl0 + ai * 128 + m * 16; const size_t r = (size_t)u.pm * 256 + rl;
                    const float* bp = blat + (r - NCTX) * D + col0; float* hp = H + r * D + col0; float ss = 0.f;
#pragma unroll
                    for (int bj = 0; bj < 2; ++bj)
#pragma unroll
                        for (int n = 0; n < 2; ++n) { const pf4 hv = *(const pf4*)(bp + bj * 128 + n * 16) + mm[bj][n] * acc[ai][bj][m][n]; acc[ai][bj][m][n] = hv;
                            ss += (hv[0] * hv[0] + hv[1] * hv[1]) + (hv[2] * hv[2] + hv[3] * hv[3]); if (mode == 0) *(pf4*)(hp + bj * 128 + n * 16) = hv; }
                    ss += __shfl_xor(ss, 16); ss += __shfl_xor(ss, 32);
                    if (fq == 0) P[rl * 4 + wc] = ss;
                    asm volatile("" ::: "memory");
                }
        }
        asm volatile("s_waitcnt lgkmcnt(0)" ::: "memory"); __builtin_amdgcn_s_barrier(); asm volatile("" ::: "memory");
        const int row = wid * 32 + (lane & 31);
        if (lane < 32) { const float t = (P[row * 4 + 0] + P[row * 4 + 1]) + (P[row * 4 + 2] + P[row * 4 + 3]);
            __hip_atomic_fetch_add(rss + (size_t)u.pm * 256 + row, (unsigned long long)(t * 16777216.f), __ATOMIC_RELAXED, __HIP_MEMORY_SCOPE_AGENT); }
        asm volatile("s_waitcnt vmcnt(0)" ::: "memory");
        if (lane == 0) __hip_atomic_fetch_add(cnt + 16 * u.pm, 1u, __ATOMIC_RELAXED, __HIP_MEMORY_SCOPE_AGENT);
        if (wid == 0) {
            unsigned sp = 0;
            while ((unsigned)__builtin_amdgcn_readfirstlane(__hip_atomic_load(cnt + 16 * u.pm, __ATOMIC_RELAXED, __HIP_MEMORY_SCOPE_AGENT)) < 32u) { __builtin_amdgcn_s_sleep(2); if (++sp > (1u << 22)) break; }
            __builtin_amdgcn_fence(__ATOMIC_ACQUIRE, "agent");
        }
        asm volatile("s_waitcnt vmcnt(0) lgkmcnt(0)" ::: "memory"); __builtin_amdgcn_s_barrier(); asm volatile("" ::: "memory");
        if (lane < 32) { const unsigned long long a = __hip_atomic_fetch_add(rss + (size_t)u.pm * 256 + row, 0ull, __ATOMIC_RELAXED, __HIP_MEMORY_SCOPE_AGENT);
            const float t = (float)a * (1.f / 16777216.f);
            S[row] = rsqrtf(t * (1.f / D) + EPS); }
        asm volatile("s_waitcnt lgkmcnt(0)" ::: "memory"); __builtin_amdgcn_s_barrier(); asm volatile("" ::: "memory");
#pragma unroll
        for (int bj = 0; bj < 2; ++bj)
#pragma unroll
            for (int n = 0; n < 2; ++n) {
                const int c = col0 + bj * 128 + n * 16;
                pf4 gm = *(const pf4*)(ng + c), sh = (pf4){0.f, 0.f, 0.f, 0.f};
                if (mode == 0) { gm = gm * (*(const pf4*)(shv + D + c) + 1.f); sh = *(const pf4*)(shv + c); }
#pragma unroll
                for (int ai = 0; ai < 2; ++ai)
#pragma unroll
                    for (int m = 0; m < 4; ++m) {
                        const int rl = rl0 + ai * 128 + m * 16; const size_t r = (size_t)u.pm * 256 + rl; const float rs = S[rl];
                        const pf4 y = acc[ai][bj][m][n] * rs * gm + sh;
                        if (mode == 0) { u32x2 w; w.x = pk2(y[0], y[1]); w.y = pk2(y[2], y[3]); *(u32x2*)(XN + r * D + c) = w; }
                        else *(pf4*)(out + (r - NCTX) * D + c) = y;
                    }
                asm volatile("" ::: "memory");
            }
        asm volatile("s_waitcnt lgkmcnt(0)" ::: "memory"); __builtin_amdgcn_s_barrier(); asm volatile("" ::: "memory");
    } };
struct EpiPartial { static constexpr bool PERM = false, AFTER_DRAIN = false; float* P; const float* mv; float mul; int kc;
    DEV void operator()(const pf4 (&acc)[2][2][4][2], const pg8::Unit& u, int wr, int wc, int fr_, int fq_) const {
        int fr = fr_, fq = fq_; asm volatile("" : "+v"(fr), "+v"(fq));
        const int row0 = (u.ko / kc) * 256 + wr * 64 + fr, col0 = u.pn * 256 + wc * 32 + 4 * fq;
#pragma unroll
        for (int ai = 0; ai < 2; ++ai)
#pragma unroll
            for (int m = 0; m < 4; ++m) {
                float* pp = P + (size_t)(row0 + ai * 128 + m * 16) * D + col0;
#pragma unroll
                for (int bj = 0; bj < 2; ++bj)
#pragma unroll
                    for (int n = 0; n < 2; ++n) *(pf4*)(pp + bj * 128 + n * 16) = *(const pf4*)(mv + col0 + bj * 128 + n * 16) * mul * acc[ai][bj][m][n];
                asm volatile("" ::: "memory");
            }
    } };
struct EpiML { static constexpr bool PERM = true, AFTER_DRAIN = false; u16* PM; float* G; const float* gb;
    DEV void operator()(const pf4 (&acc)[2][2][4][2], const pg8::Unit& u, int wr, int wc, int fr_, int fq_) const {
        int fr = fr_, fq = fq_; asm volatile("" : "+v"(fr), "+v"(fq));
        const int row0 = u.pm * 256 + wr * 64 + fr;
        if (u.pn < 12) {
            const int col0 = u.pn * 256 + wc * 32 + 8 * fq;
#pragma unroll
            for (int ai = 0; ai < 2; ++ai)
#pragma unroll
                for (int m = 0; m < 4; ++m)
#pragma unroll
                    for (int bj = 0; bj < 2; ++bj) { const pf4 a = acc[ai][bj][m][0], b = acc[ai][bj][m][1];
                        u32x4 w; w.x = pk2(a[0], a[1]); w.y = pk2(a[2], a[3]); w.z = pk2(b[0], b[1]); w.w = pk2(b[2], b[3]);
                        *(u32x4*)(PM + (size_t)(row0 + ai * 128 + m * 16) * PMW + col0 + bj * 128) = w; }
        } else if (wc == 0) {
            const pf4 b0 = *(const pf4*)(gb + 8 * fq), b1 = *(const pf4*)(gb + 8 * fq + 4);
#pragma unroll
            for (int ai = 0; ai < 2; ++ai)
#pragma unroll
                for (int m = 0; m < 4; ++m) { float* gp = G + (size_t)(row0 + ai * 128 + m * 16) * 32 + 8 * fq; *(pf4*)gp = acc[ai][0][m][0] + b0; *(pf4*)(gp + 4) = acc[ai][0][m][1] + b1; }
        }
    } };
struct EpiAB { static constexpr bool PERM = false, AFTER_DRAIN = false; u16* P0; const float* gng; const float* qg; const float* kg; const float* rt;
    static DEV void store16(u16* dp, const pf4 (&v)[2][2]) {
#pragma unroll
        for (int bj = 0; bj < 2; ++bj)
#pragma unroll
            for (int n = 0; n < 2; ++n) { u32x2 w; w.x = pk2(v[bj][n][0], v[bj][n][1]); w.y = pk2(v[bj][n][2], v[bj][n][3]); *(u32x2*)(dp + 32 * bj + 16 * n) = w; }
    }
    DEV void operator()(const pf4 (&acc)[2][2][4][2], const pg8::Unit& u, int wr, int wc, int fr_, int fq_) const {
        int fr = fr_, fq = fq_; asm volatile("" : "+v"(fr), "+v"(fq));
        const int row0 = u.pm * 256 + wr * 64 + fr, colw = u.pn * 256 + wc * 64 + 4 * fq;
        const int kind = u.pn < 2 ? 0 : (u.pn < 4 ? 1 : (u.pn < 6 ? 2 : (wc < 2 ? 3 : 4)));
        if (kind == 0 || kind == 4) {
#pragma unroll
            for (int ai = 0; ai < 2; ++ai)
#pragma unroll
                for (int m = 0; m < 4; ++m) {
                    pf4 v[2][2];
#pragma unroll
                    for (int bj = 0; bj < 2; ++bj)
#pragma unroll
                        for (int n = 0; n < 2; ++n)
#pragma unroll
                            for (int j = 0; j < 4; ++j) v[bj][n][j] = kind == 0 ? fast_gelu(acc[ai][bj][m][n][j]) : acc[ai][bj][m][n][j];
                    store16(P0 + (size_t)(row0 + ai * 128 + m * 16) * EVEN_IN + colw, v);
                    asm volatile("" ::: "memory");
                }
            return;
        }
        const float* gp = kind == 1 ? gng + (colw - 512) : (kind == 2 ? qg : kg) + 4 * fq;
        const bool rope = kind >= 2 && u.pm > 0;
        const float osc = kind == 2 ? C2 : 1.f;
#pragma unroll
        for (int ai = 0; ai < 2; ++ai)
#pragma unroll
            for (int m = 0; m < 4; ++m) {
                const int r = row0 + ai * 128 + m * 16;
                pf4 v[2][2]; float ss = 0.f;
#pragma unroll
                for (int bj = 0; bj < 2; ++bj)
#pragma unroll
                    for (int n = 0; n < 2; ++n)
#pragma unroll
                        for (int j = 0; j < 4; ++j) { const float a = acc[ai][bj][m][n][j]; const float x = kind == 1 ? fast_gelu(a) : a; v[bj][n][j] = x; ss += x * x; }
                ss += __shfl_xor(ss, 16); ss += __shfl_xor(ss, 32);
                const float rs = rsqrtf(ss * (1.f / 64) + EPS) * osc;
#pragma unroll
                for (int bj = 0; bj < 2; ++bj)
#pragma unroll
                    for (int n = 0; n < 2; ++n) v[bj][n] = v[bj][n] * rs * *(const pf4*)(gp + 32 * bj + 16 * n);
                if (rope) {
                    const int t = r - NCTX;
#pragma unroll
                    for (int bj = 0; bj < 2; ++bj) {
                        const float* tp = rt + (bj == 0 ? (t >> 6) : (t & 63)) * 32 + 4 * fq;
                        const pf4 cs = *(const pf4*)tp, sn = *(const pf4*)(tp + 16);
                        const pf4 x1 = v[bj][0], x2 = v[bj][1]; v[bj][0] = x1 * cs - x2 * sn; v[bj][1] = x2 * cs + x1 * sn;
                    }
                }
                store16(P0 + (size_t)r * EVEN_IN + colw, v);
                asm volatile("" ::: "memory");
            }
    } };

#include <hip/hip_bf16.h>
namespace attn_body {
using bf16=__hip_bfloat16;
using bf16x8=__attribute__((ext_vector_type(8)))short;
using s16x4=__attribute__((ext_vector_type(4)))short;
using f32x16=__attribute__((ext_vector_type(16)))float;
using u32x4=__attribute__((ext_vector_type(4)))unsigned;
constexpr int D=64,PQ=1792,PO=1024;
constexpr int NW=8,QBLK=32,QB=QBLK*NW,KVBLK=64;
__device__ __forceinline__ int crow(int r,int hi){return (r&3)+8*(r>>2)+4*hi;}
#define SBAR() __builtin_amdgcn_sched_barrier(0)
__device__ __forceinline__ void cmask(f32x16&p0,f32x16&p1,int jb,int qrel,int hi){
  const float NEG=-INFINITY; int kb=64*jb+4*hi;
  #pragma unroll
  for(int r=0;r<16;++r){int kv=kb+(r&3)+8*(r>>2); if(kv>qrel)p0[r]=NEG; if(kv+32>qrel)p1[r]=NEG;}
}

constexpr int NSLOT=3, SLOTB=8192;
constexpr int LDS_K=0, LDS_V=NSLOT*SLOTB, LDS_WS=2*NSLOT*SLOTB, LDS_OST=LDS_WS+NW*64*4, LDS_BYTES=LDS_OST+NW*4096;
constexpr float C2=0.125f*1.4426950408889634f;
__device__ __forceinline__ void glds16(const void*gsrc,unsigned lds_dst){unsigned keep;
  asm volatile("s_mov_b32 %0, m0\n\ts_mov_b32 m0, %2\n\ts_nop 0\n\tglobal_load_lds_dwordx4 %1, off\n\ts_mov_b32 m0, %0":"=&s"(keep):"v"(gsrc),"s"(lds_dst):"memory");}
__device__ __forceinline__ float max3f(float a,float b,float c){float r;asm("v_max3_f32 %0, %1, %2, %3":"=v"(r):"v"(a),"v"(b),"v"(c));return r;}
__device__ __forceinline__ float max2f(float a,float b){float r;asm("v_max_f32_e32 %0, %1, %2":"=v"(r):"v"(a),"v"(b));return r;}
__device__ __forceinline__ float fadd_s(float a,float b){float r;asm("v_add_f32_e32 %0, %1, %2":"=v"(r):"v"(a),"v"(b));return r;}
__device__ __forceinline__ float fsub_s(float a,float b){float r;asm("v_sub_f32_e32 %0, %1, %2":"=v"(r):"v"(a),"v"(b));return r;}
typedef float f32x2_t __attribute__((ext_vector_type(2))); typedef __bf16 bf16x2_t __attribute__((ext_vector_type(2)));
__device__ __forceinline__ unsigned cvtpk_s(float lo,float hi){f32x2_t v={lo,hi};bf16x2_t b=__builtin_convertvector(v,bf16x2_t);return __builtin_bit_cast(unsigned,b);}
#define WAIT_BAR(N) asm volatile("s_waitcnt vmcnt(" #N ") lgkmcnt(0)\n\ts_barrier":::"memory")

__device__ __forceinline__ void qkt(f32x16&p0,f32x16&p1,const char*Kslot,const bf16x8*qr,const f32x16&negm,int r32,int hi){
  const char*kb=Kslot+hi*1024+r32*16;
  #pragma unroll
  for(int d0=0;d0<4;++d0){
    const bf16x8 b0=*reinterpret_cast<const bf16x8*>(kb+d0*2048);
    const bf16x8 b1=*reinterpret_cast<const bf16x8*>(kb+d0*2048+512);
    if(d0==0){p0=__builtin_amdgcn_mfma_f32_32x32x16_bf16(b0,qr[0],negm,0,0,0);p1=__builtin_amdgcn_mfma_f32_32x32x16_bf16(b1,qr[0],negm,0,0,0);}
    else{p0=__builtin_amdgcn_mfma_f32_32x32x16_bf16(b0,qr[d0],p0,0,0,0);p1=__builtin_amdgcn_mfma_f32_32x32x16_bf16(b1,qr[d0],p1,0,0,0);}}
}
typedef __attribute__((address_space(3))) const char* lds_cptr;
typedef short v4i16_t __attribute__((ext_vector_type(4)));
__device__ __forceinline__ void kload8(bf16x8*kf,lds_cptr kp){
  kf[0]=*(const __attribute__((address_space(3))) bf16x8*)(kp);      kf[1]=*(const __attribute__((address_space(3))) bf16x8*)(kp+512);
  kf[2]=*(const __attribute__((address_space(3))) bf16x8*)(kp+2048); kf[3]=*(const __attribute__((address_space(3))) bf16x8*)(kp+2560);
  kf[4]=*(const __attribute__((address_space(3))) bf16x8*)(kp+4096); kf[5]=*(const __attribute__((address_space(3))) bf16x8*)(kp+4608);
  kf[6]=*(const __attribute__((address_space(3))) bf16x8*)(kp+6144); kf[7]=*(const __attribute__((address_space(3))) bf16x8*)(kp+6656);
}
__device__ __forceinline__ void kload2(bf16x8*kf,lds_cptr kp,int j){ kf[2*j]=*(const __attribute__((address_space(3))) bf16x8*)(kp+j*2048); kf[2*j+1]=*(const __attribute__((address_space(3))) bf16x8*)(kp+j*2048+512); }
__device__ __forceinline__ s16x4 vtr(lds_cptr p){ return __builtin_bit_cast(s16x4,__builtin_amdgcn_ds_read_tr16_b64_v4i16((__attribute__((address_space(3))) v4i16_t*)p)); }
__device__ __forceinline__ float rowmax(const f32x16&p0,const f32x16&p1){
  float a=max3f(p0[0],p0[1],p1[0]),b=max3f(p0[2],p0[3],p1[1]);a=max3f(a,p1[2],p1[3]);
  #pragma unroll
  for(int r=4;r<16;r+=4){a=max3f(a,p0[r],p0[r+1]);b=max3f(b,p0[r+2],p0[r+3]);a=max3f(a,p1[r],p1[r+1]);b=max3f(b,p1[r+2],p1[r+3]);}
  const float m=max2f(a,b);
  auto rr=__builtin_amdgcn_permlane32_swap(__float_as_uint(m),__float_as_uint(m),false,false);
  return max2f(__uint_as_float(rr[0]),__uint_as_float(rr[1]));
}
__device__ __forceinline__ void pv(f32x16*o,int vb,bf16x8 pa0,bf16x8 pa1,bf16x8 pa2,bf16x8 pa3){
  #pragma unroll
  for(int d0=0;d0<2;++d0){s16x4 lo[4],hi[4];
    #pragma unroll
    for(int ks=0;ks<4;++ks){
      asm volatile("ds_read_b64_tr_b16 %0,%1 offset:%c2":"=&v"(lo[ks]):"v"(vb),"i"(d0*4096+ks*1024):"memory");
      asm volatile("ds_read_b64_tr_b16 %0,%1 offset:%c2":"=&v"(hi[ks]):"v"(vb),"i"(d0*4096+ks*1024+512):"memory");}
    asm volatile("s_waitcnt lgkmcnt(0)":::"memory");SBAR();
    #define PK(k) (bf16x8){lo[k][0],lo[k][1],lo[k][2],lo[k][3],hi[k][0],hi[k][1],hi[k][2],hi[k][3]}
    o[d0]=__builtin_amdgcn_mfma_f32_32x32x16_bf16(pa0,PK(0),o[d0],0,0,0);
    o[d0]=__builtin_amdgcn_mfma_f32_32x32x16_bf16(pa1,PK(1),o[d0],0,0,0);
    o[d0]=__builtin_amdgcn_mfma_f32_32x32x16_bf16(pa2,PK(2),o[d0],0,0,0);
    o[d0]=__builtin_amdgcn_mfma_f32_32x32x16_bf16(pa3,PK(3),o[d0],0,0,0);
    #undef PK
  }
}

#ifndef ATTN_STORE16
#define ATTN_STORE16(p,v) (*(u32x4*)(p)=(v))
#endif
template<int THRL> __device__ __forceinline__ void attn_unit(float sref,int q0,int NT,const bf16*Q,const bf16*__restrict__ Kh,const bf16*__restrict__ Vh,bf16*O,char*shm){
  const int tid=tid_fresh(),lane=tid&63,r32=lane&31,hi=lane>>5; const int wid=__builtin_amdgcn_readfirstlane(tid>>6);
  const bf16*Qw=Q+(long)(q0+wid*QBLK)*PQ;
  const unsigned lds0=(unsigned)(uintptr_t)shm;
  float*wsf=(float*)(shm+LDS_WS)+wid*64;
  const bf16*ksrc=Kh+(long)lane*PQ+wid*8;
  const bf16*vsrc=Vh+(long)(16*(wid&3)+(lane>>2))*PQ+(wid>>2)*32+(lane&3)*8;
  const unsigned kdst=lds0+LDS_K+wid*1024, vdst=lds0+LDS_V+wid*1024;
  #define DMA_K(t,slot) glds16(ksrc+(long)(t)*KVBLK*PQ,(unsigned)__builtin_amdgcn_readfirstlane(kdst+(slot)))
  #define DMA_V(t,slot) glds16(vsrc+(long)(t)*KVBLK*PQ,(unsigned)__builtin_amdgcn_readfirstlane(vdst+(slot)))
  const int vb0=(int)(lds0+LDS_V)+((lane>>4)&1)*32+(lane&3)*8+(4*hi+((lane&15)>>2))*64;
  const char*Kbase=shm+LDS_K; bf16x8 kf[8];
  const lds_cptr shm3=(lds_cptr)shm; const lds_cptr kp0=shm3+LDS_K+hi*1024+r32*16; const lds_cptr vp0=shm3+LDS_V+((lane>>4)&1)*32+(lane&3)*8+(4*hi+((lane&15)>>2))*64;
  DMA_K(0,0);DMA_V(0,0);DMA_K(1,SLOTB);
  bf16x8 qr[4];
  #pragma unroll
  for(int d0=0;d0<4;++d0)qr[d0]=*reinterpret_cast<const bf16x8*>(&Qw[(long)r32*PQ+d0*16+hi*8]);
  float mhat=0.f,l_reg=0.f;f32x16 o[2];o[0]=f32x16{};o[1]=f32x16{};f32x16 negm=f32x16{};asm volatile("":"+v"(negm));
  #define CMASK(P0,P1,t) do{}while(0)
  bool resc=false;
  #define START(P0,P1) do{ const float rm=FIXEDREF?sref:rowmax(P0,P1); resc=false; \
    { const float dl=rm; mhat=fadd_s(mhat,dl); \
      _Pragma("unroll") for(int r=0;r<16;++r){P0[r]=fsub_s(P0[r],dl);P1[r]=fsub_s(P1[r],dl);} \
      _Pragma("unroll") for(int r=0;r<16;++r)negm[r]=-mhat; asm volatile("":"+v"(negm)); } \
    _Pragma("unroll") for(int r=0;r<16;++r)P0[r]=__builtin_amdgcn_exp2f(P0[r]); }while(0)
  #define RESC() do{ if(resc){ asm volatile("s_waitcnt lgkmcnt(0)":::"memory"); \
      _Pragma("unroll") for(int d_=0;d_<2;++d_) _Pragma("unroll") for(int r=0;r<16;++r)o[d_][r]*=wsf[crow(r,hi)]; } }while(0)
  f32x16 pA0,pA1,pB0,pB1;
  int sl_prev=0,sl_cur=0,sl_next=SLOTB;
  #define ROT() do{sl_prev=sl_cur;sl_cur=sl_next;sl_next=(sl_next==(NSLOT-1)*SLOTB)?0:sl_next+SLOTB;}while(0)
  DMA_K(2,2*SLOTB);
  WAIT_BAR(3);
  qkt(pA0,pA1,Kbase,qr,negm,r32,hi);asm volatile("s_nop 15\n\ts_nop 7":"+v"(pA0),"+v"(pA1));CMASK(pA0,pA1,0);
  START(pA0,pA1);
  _Pragma("unroll") for(int r=0;r<16;++r)pA1[r]=__builtin_amdgcn_exp2f(pA1[r]);
  WAIT_BAR(0);
  DMA_K(3,0);DMA_V(1,SLOTB);
  ROT();
  kload8(kf,kp0+sl_cur);
  WAIT_BAR(2);
  s16x4 vlo[8],vhi[8]; u32x4 pw0,pw1,pw2,pw3;
  #define PKW(P,B) cvtpk_s(P[B],P[B+1])
  #define PAF(k) __builtin_bit_cast(bf16x8,pw##k)
  #define VFR(i) (bf16x8){vlo[i][0],vlo[i][1],vlo[i][2],vlo[i][3],vhi[i][0],vhi[i][1],vhi[i][2],vhi[i][3]}
  #define PIN(x) asm volatile("":"+v"(x))
  #define MX3(a,b,c) __builtin_fmaxf(__builtin_fmaxf((a),(b)),(c))
  #define GAPA(MF,A0,A1,A2,A3,W0,W1,PW) do{ MF; sacc+=A0; sacc+=A1; sacc+=A2; sacc+=A3; PIN(sacc); W0; W1; PIN(PW); SBAR(); }while(0)
  #define EX(v) __builtin_amdgcn_exp2f(v)
  #define GAPB(MF,X,B) do{ MF; X[B]=EX(X[B]); X[B+1]=EX(X[B+1]); X[B+2]=EX(X[B+2]); X[B+3]=EX(X[B+3]); PIN(X); SBAR(); }while(0)
  #define VRD(i) do{ vlo[i]=vtr(vp_+(((i)>>2)*4096+((i)&3)*1024)); vhi[i]=vtr(vp_+(((i)>>2)*4096+((i)&3)*1024+512)); }while(0)
  #define KRD(G,j) do{ if(G){ kload2(kf,kp0+sl_next,j); SBAR(); } }while(0)
  #define STEP(C0,C1,P0,P1,t,GK,GV,GL) do{ SBAR(); \
    const lds_cptr vp_=vp0+sl_prev; \
    VRD(0); SBAR(); float sacc=(P0[0]+P0[1]); \
    GAPA(C0=__builtin_amdgcn_mfma_f32_32x32x16_bf16(kf[0],qr[0],negm,0,0,0), P0[2],P0[3],P0[4],P0[5],     pw0[0]=PKW(P0,0), pw0[1]=PKW(P0,2), pw0); \
    VRD(4); SBAR(); GAPA(C1=__builtin_amdgcn_mfma_f32_32x32x16_bf16(kf[1],qr[0],negm,0,0,0), P0[6],P0[7],P0[8],P0[9],     pw0[2]=PKW(P0,4), pw0[3]=PKW(P0,6), pw0); \
    VRD(1); SBAR(); GAPA(C0=__builtin_amdgcn_mfma_f32_32x32x16_bf16(kf[2],qr[1],C0,0,0,0),   P0[10],P0[11],P0[12],P0[13], pw1[0]=PKW(P0,8), pw1[1]=PKW(P0,10), pw1); \
    VRD(5); SBAR(); GAPA(C1=__builtin_amdgcn_mfma_f32_32x32x16_bf16(kf[3],qr[1],C1,0,0,0),   P0[14],P0[15],P1[0],P1[1],   pw1[2]=PKW(P0,12),pw1[3]=PKW(P0,14), pw1); \
    VRD(2); SBAR(); GAPA(C0=__builtin_amdgcn_mfma_f32_32x32x16_bf16(kf[4],qr[2],C0,0,0,0),   P1[2],P1[3],P1[4],P1[5],     pw2[0]=PKW(P1,0), pw2[1]=PKW(P1,2), pw2); \
    VRD(6); SBAR(); GAPA(C1=__builtin_amdgcn_mfma_f32_32x32x16_bf16(kf[5],qr[2],C1,0,0,0),   P1[6],P1[7],P1[8],P1[9],     pw2[2]=PKW(P1,4), pw2[3]=PKW(P1,6), pw2); \
    VRD(3); SBAR(); GAPA(C0=__builtin_amdgcn_mfma_f32_32x32x16_bf16(kf[6],qr[3],C0,0,0,0),   P1[10],P1[11],P1[12],P1[13], pw3[0]=PKW(P1,8), pw3[1]=PKW(P1,10), pw3); \
    VRD(7); SBAR(); GAPA(C1=__builtin_amdgcn_mfma_f32_32x32x16_bf16(kf[7],qr[3],C1,0,0,0),   P1[14],P1[15],0.f,0.f,       pw3[2]=PKW(P1,12),pw3[3]=PKW(P1,14), pw3); \
    l_reg+=sacc; \
    if(GK){DMA_K((t)+3,sl_cur);} if(GV){DMA_V((t)+1,sl_next);} \
    CMASK(C0,C1,t); \
    { float a=MX3(C0[0],C0[1],C1[0]),b=MX3(C0[2],C0[3],C1[1]); a=MX3(a,C1[2],C1[3]); \
      _Pragma("unroll") for(int r=4;r<16;r+=4){a=MX3(a,C0[r],C0[r+1]);b=MX3(b,C0[r+2],C0[r+3]);a=MX3(a,C1[r],C1[r+1]);b=MX3(b,C1[r+2],C1[r+3]);} \
      float rm=__builtin_fmaxf(a,b); { auto rr=__builtin_amdgcn_permlane32_swap(__float_as_uint(rm),__float_as_uint(rm),false,false); rm=__builtin_fmaxf(__uint_as_float(rr[0]),__uint_as_float(rr[1])); } \
      resc=false; \
      if(!FIXEDREF&&__builtin_expect(__any(rm>(float)THRL),0)){ const float dl=__builtin_fmaxf(rm,0.f); mhat+=dl; \
        _Pragma("unroll") for(int r=0;r<16;++r){C0[r]-=dl;C1[r]-=dl;} \
        _Pragma("unroll") for(int r=0;r<16;++r)negm[r]=-mhat; asm volatile("":"+v"(negm)); \
        const float f=__builtin_amdgcn_exp2f(-dl); l_reg*=f; if(hi==0)wsf[r32]=f; resc=true; } } \
    SBAR(); \
    GAPB(o[0]=__builtin_amdgcn_mfma_f32_32x32x16_bf16(PAF(0),VFR(0),o[0],0,0,0), C0,0); \
    GAPB(o[1]=__builtin_amdgcn_mfma_f32_32x32x16_bf16(PAF(0),VFR(4),o[1],0,0,0), C0,4); \
    KRD(GL,0); GAPB(o[0]=__builtin_amdgcn_mfma_f32_32x32x16_bf16(PAF(1),VFR(1),o[0],0,0,0), C0,8); \
    KRD(GL,1); GAPB(o[1]=__builtin_amdgcn_mfma_f32_32x32x16_bf16(PAF(1),VFR(5),o[1],0,0,0), C0,12); \
    KRD(GL,2); GAPB(o[0]=__builtin_amdgcn_mfma_f32_32x32x16_bf16(PAF(2),VFR(2),o[0],0,0,0), C1,0); \
    KRD(GL,3); GAPB(o[1]=__builtin_amdgcn_mfma_f32_32x32x16_bf16(PAF(2),VFR(6),o[1],0,0,0), C1,4); \
    GAPB(o[0]=__builtin_amdgcn_mfma_f32_32x32x16_bf16(PAF(3),VFR(3),o[0],0,0,0), C1,8); \
    GAPB(o[1]=__builtin_amdgcn_mfma_f32_32x32x16_bf16(PAF(3),VFR(7),o[1],0,0,0), C1,12); \
    }while(0)
  int t=1;
  #undef CMASK
  #define CMASK(P0,P1,t) do{}while(0)
  for(;t+5<NT;t+=2){
    STEP(pB0,pB1,pA0,pA1,t,true,true,true);     WAIT_BAR(2); RESC(); ROT();
    STEP(pA0,pA1,pB0,pB1,t+1,true,true,true);   WAIT_BAR(2); RESC(); ROT();
  }
  #undef CMASK
  #define CMASK(P0,P1,t) do{}while(0)
  #define ENDW(tt) do{ if((tt)+3<NT){WAIT_BAR(2);} else if((tt)+2<NT){WAIT_BAR(1);} else {WAIT_BAR(0);} }while(0)
  for(;t+1<NT;t+=2){
    STEP(pB0,pB1,pA0,pA1,t,(t+3<NT),(t+1<NT),(t+1<NT));       ENDW(t);   RESC(); ROT();
    STEP(pA0,pA1,pB0,pB1,t+1,(t+4<NT),(t+2<NT),(t+2<NT));     ENDW(t+1); RESC(); ROT();
  }
  STEP(pB0,pB1,pA0,pA1,NT-1,false,false,false); RESC();
  { float sacc=pB0[0]+pB0[1]; _Pragma("unroll") for(int r=2;r<16;++r)sacc+=pB0[r]; _Pragma("unroll") for(int r=0;r<16;++r)sacc+=pB1[r]; l_reg+=sacc;
    pw0=(u32x4){PKW(pB0,0),PKW(pB0,2),PKW(pB0,4),PKW(pB0,6)};pw1=(u32x4){PKW(pB0,8),PKW(pB0,10),PKW(pB0,12),PKW(pB0,14)};pw2=(u32x4){PKW(pB1,0),PKW(pB1,2),PKW(pB1,4),PKW(pB1,6)};pw3=(u32x4){PKW(pB1,8),PKW(pB1,10),PKW(pB1,12),PKW(pB1,14)};
    SBAR(); pv(o,vb0+sl_cur,PAF(0),PAF(1),PAF(2),PAF(3)); }
  #undef PKW
  #undef PAF
  #undef VFR
  #undef PIN
  #undef MX3
  #undef GAPA
  #undef GAPB
  #undef EX
  #undef VRD
  #undef KRD
  #undef STEP
  #undef ENDW
  {auto rr=__builtin_amdgcn_permlane32_swap(__float_as_uint(l_reg),__float_as_uint(l_reg),false,false);l_reg=__uint_as_float(rr[0])+__uint_as_float(rr[1]);}
  if(hi==0)wsf[32+r32]=l_reg;asm volatile("s_waitcnt lgkmcnt(0)":::"memory");
  float rli[16];
  #pragma unroll
  for(int r=0;r<16;++r)rli[r]=__builtin_amdgcn_rcpf(wsf[32+crow(r,hi)]);
  bf16*Ow=O+(long)(q0+wid*QBLK)*PO;
  { bf16*stg=(bf16*)(shm+LDS_OST)+wid*2048;
    #pragma unroll
    for(int r=0;r<16;++r){const int orow=crow(r,hi);
      #pragma unroll
      for(int d0=0;d0<2;++d0)stg[orow*64+d0*32+r32]=__float2bfloat16(o[d0][r]*rli[r]);}
    asm volatile("s_waitcnt lgkmcnt(0)":::"memory");
    #pragma unroll
    for(int i=0;i<4;++i){const int row=i*8+(lane>>3),ch=lane&7; const u32x4 v=*(const u32x4*)(stg+row*64+ch*8); ATTN_STORE16(Ow+(long)row*PO+ch*8,v);} }
  asm volatile("s_waitcnt lgkmcnt(0)\n\ts_barrier":::"memory");
  #undef DMA_K
  #undef DMA_V
  #undef CMASK
  #undef START
  #undef RESC
  #undef ROT
}
constexpr int ATTN_LDS_BYTES=LDS_BYTES;
#undef SBAR
#undef WAIT_BAR
}

DEV void phase_attn_fast(const Ctx& X, char* shm) {
    typedef attn_body::bf16 abf;
    const abf* P0 = (const abf*)X.BIG; abf* CAT = (abf*)X.XN;
    const int G = gridDim.x, bx = blockIdx.x, x8 = (G % 8 == 0), vcu = x8 ? (bx % 8) * (G / 8) + bx / 8 : bx;
    const int per = (512 + G - 1) / G;
    float mq = 0.f, mk = 0.f;
    for (int d = 0; d < 64; ++d) { mq = fmaxf(mq, fabsf(X.ab_q_norm_g[d])); mk = fmaxf(mk, fabsf(X.ab_k_norm_g[d])); }
    const float sref = 1.02f * C2 * 64.f * mq * mk;
    for (int i = 0; i < per; ++i) {
        const int u = vcu * per + i; if (u >= 512) break;
        const int h = u >> 6, qb = u & 63;
        attn_body::attn_unit<8>(sref, NCTX + qb * 256, R / 64, P0 + 1024 + h * 64, P0 + 1536 + (h >> 2) * 64, P0 + 1664 + (h >> 2) * 64, CAT + 512 + h * 64, shm);
    }
    for (int h = 0; h < 8; ++h) if (vcu == (x8 ? h * (G / 8) : h))
        attn_body::attn_unit<8>(sref, 0, NCTX / 64, P0 + 1024 + h * 64, P0 + 1536 + (h >> 2) * 64, P0 + 1664 + (h >> 2) * 64, CAT + 512 + h * 64, shm);
}


#define LAS __attribute__((address_space(3)))
typedef short v4i16_t __attribute__((ext_vector_type(4)));
typedef LAS unsigned char* lptr;
DEV bf16x8 mk8(v4i16_t a, v4i16_t b) { return __builtin_shufflevector(a, b, 0, 1, 2, 3, 4, 5, 6, 7); }
DEV bf16x8 tr_frag(lptr tile, int stride, int k0, int x0, int lane) {
    const int g = lane >> 4, q = (lane & 15) >> 2, p = lane & 3;
    lptr a = tile + (k0 + 8 * g + q) * stride + (x0 + 4 * p) * 2;
    const v4i16_t v0 = __builtin_amdgcn_ds_read_tr16_b64_v4i16((LAS v4i16_t*)a), v1 = __builtin_amdgcn_ds_read_tr16_b64_v4i16((LAS v4i16_t*)(a + 4 * stride));
    return mk8(v0, v1);
}
#define MFMA16(a, b, c) __builtin_amdgcn_mfma_f32_16x16x32_bf16(a, b, c, 0, 0, 0)

DEV void phase_sgu_fast(const Ctx& X, lptr L) {
    const u16* P0 = X.BIG; u16* CAT = X.XN; constexpr int SV = 528;
    const int lane = X.lane, w = X.wave, fi = lane & 15, fg = lane >> 4;
    for (int it = blockIdx.x; it < NPC * 2; it += gridDim.x) {
        const int pc = it >> 1, half = it & 1;
        __syncthreads();
        for (int c = X.tid; c < 128 * 32; c += NTHR) { const int row = c >> 5, ch = c & 31;
            *(LAS u32x4*)(L + row * SV + ch * 16) = *(const u32x4*)(P0 + (size_t)(pc * 128 + row) * EVEN_IN + 512 + half * 256 + ch * 8); }
        __syncthreads();
        const int gl = w >> 1, mh = w & 1, g = half * 4 + gl;
        f32x4 acc[4][4];
#pragma unroll
        for (int a = 0; a < 4; ++a)
#pragma unroll
            for (int b = 0; b < 4; ++b) acc[a][b] = (f32x4){0.f, 0.f, 0.f, 0.f};
        const u16* Wg = X.SPW + (size_t)g * 128 * 128 + (size_t)(64 * mh + fi) * 128 + 8 * fg;
#pragma unroll
        for (int ks = 0; ks < 4; ++ks) {
            bf16x8 af[4], bfr[4];
#pragma unroll
            for (int mt = 0; mt < 4; ++mt) af[mt] = *(const bf16x8*)(Wg + (size_t)(16 * mt) * 128 + 32 * ks);
#pragma unroll
            for (int nt = 0; nt < 4; ++nt) bfr[nt] = tr_frag(L, SV, 32 * ks, gl * 64 + 16 * nt, lane);
#pragma unroll
            for (int mt = 0; mt < 4; ++mt)
#pragma unroll
                for (int nt = 0; nt < 4; ++nt) acc[mt][nt] = MFMA16(af[mt], bfr[nt], acc[mt][nt]);
        }
#pragma unroll
        for (int mt = 0; mt < 4; ++mt)
#pragma unroll
            for (int j = 0; j < 4; ++j) {
                const int t = 64 * mh + 16 * mt + 4 * fg + j; const size_t row = (size_t)pc * 128 + t; const float bias = X.ab_spatial_b[g * 128 + t];
#pragma unroll
                for (int nt = 0; nt < 4; ++nt) { const int col = g * 64 + 16 * nt + fi; CAT[row * D + col] = f2bf(bf2f(P0[row * EVEN_IN + col]) * (acc[mt][nt][j] + bias)); }
            }
    }
}

DEV void phase_m1_fast(const Ctx& X, lptr L) {
    const u16* PM = X.BIG; const u16* QKC = X.XN; constexpr int SV = 272, SK = 144;
    lptr LV = L, LK0 = L + 128 * SV, LK1 = LK0 + 128 * SK;
    const int lane = X.lane, w = X.wave, fi = lane & 15, fg = lane >> 4;
    for (int it = blockIdx.x; it < 8 * NPC; it += gridDim.x) {
        const int h = it / NPC, pc = it % NPC, item0 = item_of(0, h, pc), item1 = item_of(1, h, pc);
        __syncthreads();
        for (int c = X.tid; c < 128 * 16; c += NTHR) { const int row = c >> 4, ch = c & 15;
            *(LAS u32x4*)(LV + row * SV + ch * 16) = *(const u32x4*)(PM + (size_t)(pc * 128 + row) * PMW + 1024 + h * 128 + ch * 8); }
        for (int c = X.tid; c < 128 * 8; c += NTHR) { const int row = c >> 3, ch = c & 7;
            const bf16x8 kv = *(const bf16x8*)(QKC + (size_t)(pc * 128 + row) * D + 512 + h * 64 + ch * 8);
            const float e0 = X.EE[(size_t)item0 * 128 + row], e1 = X.EE[(size_t)item1 * 128 + row];
            float f[8];
#pragma unroll
            for (int j = 0; j < 8; ++j) f[j] = bf2f((u16)kv[j]);
            u32x4 o0, o1;
            o0.x = pk2(f[0] * e0, f[1] * e0); o0.y = pk2(f[2] * e0, f[3] * e0); o0.z = pk2(f[4] * e0, f[5] * e0); o0.w = pk2(f[6] * e0, f[7] * e0);
            o1.x = pk2(f[0] * e1, f[1] * e1); o1.y = pk2(f[2] * e1, f[3] * e1); o1.z = pk2(f[4] * e1, f[5] * e1); o1.w = pk2(f[6] * e1, f[7] * e1);
            *(LAS u32x4*)(LK0 + row * SK + ch * 16) = o0; *(LAS u32x4*)(LK1 + row * SK + ch * 16) = o1; }
        __syncthreads();
        const int d = w >> 2, vq = w & 3, item = d ? item1 : item0; lptr LK = d ? LK1 : LK0;
        f32x4 acc[2][4];
#pragma unroll
        for (int a = 0; a < 2; ++a)
#pragma unroll
            for (int b = 0; b < 4; ++b) acc[a][b] = (f32x4){0.f, 0.f, 0.f, 0.f};
#pragma unroll
        for (int ks = 0; ks < 4; ++ks) {
            bf16x8 af[2], bfr[4];
#pragma unroll
            for (int mt = 0; mt < 2; ++mt) af[mt] = tr_frag(LV, SV, 32 * ks, 32 * vq + 16 * mt, lane);
#pragma unroll
            for (int nt = 0; nt < 4; ++nt) bfr[nt] = tr_frag(LK, SK, 32 * ks, 16 * nt, lane);
#pragma unroll
            for (int mt = 0; mt < 2; ++mt)
#pragma unroll
                for (int nt = 0; nt < 4; ++nt) acc[mt][nt] = MFMA16(af[mt], bfr[nt], acc[mt][nt]);
        }
        float* co = X.CLOC + (size_t)item * 8192;
#pragma unroll
        for (int mt = 0; mt < 2; ++mt)
#pragma unroll
            for (int nt = 0; nt < 4; ++nt)
#pragma unroll
                for (int j = 0; j < 4; ++j) co[(32 * vq + 16 * mt + 4 * fg + j) * 64 + 16 * nt + fi] = acc[mt][nt][j];
        if (X.tid < 128) { const int dd = X.tid >> 6, kk = X.tid & 63; lptr lk = dd ? LK1 : LK0; float s = 0.f;
            for (int p = 0; p < 128; ++p) s += bf2f(*(LAS u16*)(lk + p * SK + kk * 2));
            X.NLOC[(size_t)(dd ? item1 : item0) * 64 + kk] = s; }
    }
}

DEV void phase_m3_fast(const Ctx& X, lptr L) {
    u16* PM = X.BIG; const u16* QKC = X.XN; constexpr int SV = 272, SC = 144, SP = 272;
    lptr LV = L, LC0 = L + 128 * SV, LC1 = LC0 + 128 * SC, LNI = LC1 + 128 * SC  , LP = LNI + 256;
    const int lane = X.lane, w = X.wave, fi = lane & 15, fg = lane >> 4;
    lptr LPw = LP + w * (16 * SP);
    for (int it = blockIdx.x; it < 8 * (NLAT / 128); it += gridDim.x) {
        const int h = it / (NLAT / 128), pc = 2 + it % (NLAT / 128); const size_t r0 = (size_t)pc * 128;
        __syncthreads();
        for (int c = X.tid; c < 128 * 16; c += NTHR) { const int row = c >> 4, ch = c & 15;
            *(LAS u32x4*)(LV + row * SV + ch * 16) = *(const u32x4*)(PM + (r0 + row) * PMW + 1024 + h * 128 + ch * 8); }
        for (int c = X.tid; c < 2 * 128 * 8; c += NTHR) { const int dd = c >> 10, row = (c >> 3) & 127, ch = c & 7;
            const float* src = X.CLOC + (size_t)item_of(dd, h, pc) * 8192 + row * 64 + ch * 8; const f32x4 a = *(const f32x4*)src, b = *(const f32x4*)(src + 4);
            u32x4 o; o.x = pk2(a.x, a.y); o.y = pk2(a.z, a.w); o.z = pk2(b.x, b.y); o.w = pk2(b.z, b.w);
            *(LAS u32x4*)((dd ? LC1 : LC0) + row * SC + ch * 16) = o; }
        if (X.tid < 128) { const int dd = X.tid >> 6, kk = X.tid & 63; *(LAS u16*)(LNI + (dd * 64 + kk) * 2) = f2bf(X.NLOC[(size_t)item_of(dd, h, pc) * 64 + kk]); }
        __syncthreads();
        bf16x8 qf[2];
#pragma unroll
        for (int ks = 0; ks < 2; ++ks) qf[ks] = *(const bf16x8*)(QKC + (r0 + 16 * w + fi) * D + h * 64 + 32 * ks + 8 * fg);
        f32x4 hs[8];
#pragma unroll
        for (int nt = 0; nt < 8; ++nt) hs[nt] = (f32x4){0.f, 0.f, 0.f, 0.f};
#pragma unroll 1
        for (int d = 0; d < 2; ++d) {
            const int item = item_of(d, h, pc);
            const float* bb = X.BB + (size_t)item * 128; const float* li = X.LI + (size_t)item * 128; const float* rm = X.RM + (size_t)item * 128;
            const float m_in = X.MIN[item];
            f32x4 s[8];
#pragma unroll
            for (int nt = 0; nt < 8; ++nt) {
                s[nt] = (f32x4){0.f, 0.f, 0.f, 0.f};
#pragma unroll
                for (int ks = 0; ks < 2; ++ks) { const bf16x8 kf = *(const bf16x8*)(QKC + (r0 + 16 * nt + fi) * D + 512 + h * 64 + 32 * ks + 8 * fg); s[nt] = MFMA16(qf[ks], kf, s[nt]); }
            }
            float mj[4], bj[4];
#pragma unroll
            for (int jj = 0; jj < 4; ++jj) { const int j = 16 * w + 4 * fg + jj; mj[jj] = fmaxf(m_in, rm[j]); bj[jj] = bb[j]; }
#pragma unroll
            for (int nt = 0; nt < 8; ++nt) {
                const int sidx = 16 * nt + fi; const float cs = li[sidx] - bb[sidx];
                float pv[4];
#pragma unroll
                for (int jj = 0; jj < 4; ++jj) { const int j = 16 * w + 4 * fg + jj; const bool valid = d == 0 ? (sidx <= j) : (sidx >= j); pv[jj] = valid ? s[nt][jj] * __expf(cs - mj[jj]) : 0.f; }
#pragma unroll
                for (int jj = 0; jj < 4; ++jj) *(LAS u16*)(LPw + (4 * fg + jj) * SP + sidx * 2) = f2bf(pv[jj]);
            }
            LDS_FENCE(); __syncthreads();
            const float mrow = fmaxf(m_in, rm[16 * w + fi]), brow = bb[16 * w + fi];
            const float arow = __expf(m_in - mrow);
            bf16x8 aq[2];
#pragma unroll
            for (int ks = 0; ks < 2; ++ks)
#pragma unroll
                for (int e = 0; e < 8; ++e) aq[ks][e] = (short)f2bf(bf2f((u16)qf[ks][e]) * arow);
            f32x4 num[8], den = (f32x4){0.f, 0.f, 0.f, 0.f};
#pragma unroll
            for (int nt = 0; nt < 8; ++nt) num[nt] = (f32x4){0.f, 0.f, 0.f, 0.f};
            const bf16x8 ones = (bf16x8){(short)0x3F80, (short)0x3F80, (short)0x3F80, (short)0x3F80, (short)0x3F80, (short)0x3F80, (short)0x3F80, (short)0x3F80};
#pragma unroll
            for (int ks = 0; ks < 4; ++ks) {
                const bf16x8 pf = *(LAS bf16x8*)(LPw + fi * SP + (32 * ks + 8 * fg) * 2);
#pragma unroll
                for (int nt = 0; nt < 8; ++nt) num[nt] = MFMA16(tr_frag(LV, SV, 32 * ks, 16 * nt, lane), pf, num[nt]);
                den = MFMA16(ones, pf, den);
            }
            lptr LC = d ? LC1 : LC0;
#pragma unroll
            for (int ks = 0; ks < 2; ++ks) {
#pragma unroll
                for (int nt = 0; nt < 8; ++nt) num[nt] = MFMA16(*(LAS bf16x8*)(LC + (16 * nt + fi) * SC + (32 * ks + 8 * fg) * 2), aq[ks], num[nt]);
                const bf16x8 nf = *(LAS bf16x8*)(LNI + (d * 64 + 32 * ks + 8 * fg) * 2);
                den = MFMA16(nf, aq[ks], den);
            }
            {
                const float inv = 1.f / fmaxf(fabsf(den[0]), __expf(-(brow + mrow)));
#pragma unroll
                for (int nt = 0; nt < 8; ++nt) hs[nt] = hs[nt] + num[nt] * inv;
            }
            LDS_FENCE(); __syncthreads();
        }
        {
            float ss = 0.f;
#pragma unroll
            for (int nt = 0; nt < 8; ++nt) ss += (hs[nt][0] * hs[nt][0] + hs[nt][1] * hs[nt][1]) + (hs[nt][2] * hs[nt][2] + hs[nt][3] * hs[nt][3]);
            ss += __shfl_xor(ss, 16); ss += __shfl_xor(ss, 32);
            const float rs = rsqrtf(ss * (1.f / 128) + EPS);
            u16* prow = PM + (r0 + 16 * w + fi) * PMW + h * 128 + 4 * fg;
            const float* gp = X.ml_out_norm_g + h * 128 + 4 * fg;
#pragma unroll
            for (int nt = 0; nt < 8; ++nt) {
                const u32x2 og = *(const u32x2*)(prow + 2048 + 16 * nt); const f32x4 gg = *(const f32x4*)(gp + 16 * nt);
                u32x2 o;
                o.x = pk2(hs[nt][0] * rs * gg[0] * sigmoid_f(bf2f((u16)(og.x & 0xffffu))), hs[nt][1] * rs * gg[1] * sigmoid_f(bf2f((u16)(og.x >> 16))));
                o.y = pk2(hs[nt][2] * rs * gg[2] * sigmoid_f(bf2f((u16)(og.y & 0xffffu))), hs[nt][3] * rs * gg[3] * sigmoid_f(bf2f((u16)(og.y >> 16))));
                *(u32x2*)(prow + 16 * nt) = o;
            }
        }
    }
}

#define XB_TMO      128
#define XB_XCNT(j)  (256  + 64 * (j))
#define XB_XSUB(j)  (1280 + 64 * (j))
#define XB_XGEN(j)  (2304 + 64 * (j))
#define XB_TOP      3328
#define XB_TOPGEN   3392
#define XCD_BAR_WORDS 3456
#define XB_SPIN_CAP (1u << 22)

__device__ __forceinline__ unsigned xb_ld(unsigned* p)              { return __hip_atomic_load(p, __ATOMIC_RELAXED, __HIP_MEMORY_SCOPE_AGENT); }
__device__ __forceinline__ unsigned xb_add(unsigned* p, unsigned v) { return __hip_atomic_fetch_add(p, v, __ATOMIC_RELAXED, __HIP_MEMORY_SCOPE_AGENT); }
__device__ __forceinline__ unsigned xb_xcc_id() { return (unsigned)__builtin_amdgcn_s_getreg((3 << 11) | 20) & 0xFu; }
#define XB_SPIN(cond, bar) do { unsigned _sp = 0; while (cond) { __builtin_amdgcn_s_sleep(1); \
    if ((++_sp & 255u) == 0u) { if (xb_ld(&(bar)[XB_TMO])) break; if (_sp > XB_SPIN_CAP) { atomicAdd(&(bar)[XB_TMO], 1u); break; } } } } while (0)

struct XcdBarrier {
    unsigned* bar; unsigned x;
    volatile LAS unsigned* st;
};

__device__ __forceinline__ XcdBarrier xcd_barrier_post(unsigned* bar, volatile LAS unsigned* st) {
    XcdBarrier b; b.bar = bar; b.x = xb_xcc_id(); b.st = st;
    if (threadIdx.x == 0) (void)xb_add(&bar[XB_XCNT(b.x)], 1u);
    return b;
}
__device__ __forceinline__ void xcd_barrier_complete(unsigned* bar, unsigned x, unsigned& nloc, unsigned& nx) {
    const unsigned G = gridDim.x * gridDim.y * gridDim.z;
    unsigned sum, cnt, mine, sp = 0u;
    for (;;) {
        sum = 0u; cnt = 0u; mine = 0u;
#pragma unroll
        for (unsigned j = 0; j < 16; ++j) { const unsigned c = xb_ld(&bar[XB_XCNT(j)]); sum += c; cnt += (c > 0u) ? 1u : 0u; mine = (j == x) ? c : mine; }
        if (sum == G) break;
        __builtin_amdgcn_s_sleep(1);
        if ((++sp & 255u) == 0u) { if (xb_ld(&bar[XB_TMO])) break; if (sp > XB_SPIN_CAP) { atomicAdd(&bar[XB_TMO], 1u); break; } }
    }
    nloc = mine > 0u ? mine : 1u; nx = cnt > 0u ? cnt : 1u;
}

__device__ __forceinline__ void xcd_barrier(const XcdBarrier& b) {
    asm volatile("s_waitcnt vmcnt(0)" ::: "memory");
    __syncthreads();
    if (threadIdx.x == 0) {
        unsigned* bar = b.bar;
        __builtin_amdgcn_s_waitcnt(0);
        unsigned nloc = b.st[0], nx = b.st[1];
        if (nloc == 0u) { xcd_barrier_complete(bar, b.x, nloc, nx); b.st[0] = nloc; b.st[1] = nx; }
        const unsigned old = xb_add(&bar[XB_XSUB(b.x)], 1u);
        const unsigned gen = old / nloc;
        if (old + 1u == (gen + 1u) * nloc) {
            __builtin_amdgcn_fence(__ATOMIC_RELEASE, "agent");
            asm volatile("s_waitcnt vmcnt(0)" ::: "memory");
            const unsigned og = xb_add(&bar[XB_TOP], 1u);
            const unsigned tg = og / nx;
            if (og + 1u == (tg + 1u) * nx) xb_add(&bar[XB_TOPGEN], 1u);
            else XB_SPIN(xb_ld(&bar[XB_TOPGEN]) == tg, bar);
            __builtin_amdgcn_fence(__ATOMIC_ACQUIRE, "agent");
            xb_add(&bar[XB_XGEN(b.x)], 1u);
            asm volatile("s_waitcnt vmcnt(0)" ::: "memory");
        } else {
            XB_SPIN(xb_ld(&bar[XB_XGEN(b.x)]) == gen, bar);
            __builtin_amdgcn_fence(__ATOMIC_ACQUIRE, "agent");
            asm volatile("s_waitcnt vmcnt(0)" ::: "memory");
        }
    }
    __syncthreads();
}

__global__ void __launch_bounds__(NTHR, 2) fwd_kernel(Args args) {
    extern __shared__ __attribute__((aligned(16))) unsigned char lds[];
    cg::grid_group grid = cg::this_grid();
    Ctx X;
    X.x = args.in[0]; X.c = args.in[1]; X.ctx = args.in[2]; X.c_ctx = args.in[3]; X.mod_w = args.in[4]; X.mod_b = args.in[5]; X.norm_g = args.in[6];
    X.ffn_w13 = args.in[7]; X.ffn_w2 = args.in[8]; X.ab_w_in = args.in[9]; X.ab_gate_norm_g = args.in[10]; X.ab_spatial_w = args.in[11]; X.ab_spatial_b = args.in[12];
    X.ab_q_norm_g = args.in[13]; X.ab_k_norm_g = args.in[14]; X.ab_w_out = args.in[15]; X.ml_w_in = args.in[16]; X.ml_conv_w = args.in[17]; X.ml_gate_b = args.in[18];
    X.ml_out_norm_g = args.in[19]; X.ml_w_out = args.in[20]; X.final_norm_g = args.in[21];
    X.out = args.out; unsigned char* ws = args.ws;
    X.MV = (float*)(ws + WS_MV); X.ROPE = (float*)(ws + WS_MV + 160 * KiB);
    X.MLOC = (float*)(ws + WS_MISC); X.BLAST = X.MLOC + 4096; X.MIN = X.MLOC + 8192; X.NLOC = X.MLOC + 16384;
    X.BB = (float*)(ws + WS_GS); X.LI = X.BB + NITEM * 128; X.EE = X.LI + NITEM * 128; X.RM = X.EE + NITEM * 128;
    X.G = (float*)(ws + WS_G); X.H = (float*)(ws + WS_H); X.CLOC = (float*)(ws + WS_CLOC); X.RAW = (u16*)(ws + WS_CLOC);
    X.W13T = (u16*)(ws + WS_W13T); X.W2T = (u16*)(ws + WS_W2T); X.ABIN = (u16*)(ws + WS_ABIN); X.ABOUT = (u16*)(ws + WS_ABOUT);
    X.MLIN = (u16*)(ws + WS_MLIN); X.MLOUT = (u16*)(ws + WS_MLOUT); X.SPW = (u16*)(ws + WS_SPW); X.XN = (u16*)(ws + WS_XN); X.BIG = (u16*)(ws + WS_BIG);
#define SET_TID() do { X.tid = tid_fresh(); X.lane = X.tid & 63; X.wave = __builtin_amdgcn_readfirstlane(X.tid >> 6); X.gw = blockIdx.x * NWAVES + X.wave; X.gtid = blockIdx.x * NTHR + X.tid; } while (0)
    SET_TID(); X.NGW = gridDim.x * NWAVES; X.NT = gridDim.x * NTHR;
    X.lds = lds;
    const int lo = args.ph_lo, hi = args.ph_hi;
    volatile LAS unsigned* bst = (volatile LAS unsigned*)((lptr)lds + (LDS_BYTES - 64));
    if (X.tid < 2) bst[X.tid] = 0u;
    __syncthreads();
    const XcdBarrier xbar = xcd_barrier_post((unsigned*)(ws + WS_BAR), bst);
    int ph = 0;
#define PH_BEGIN if (lo <= ph && ph < hi) { SET_TID();
#define GSYNC() do { __builtin_amdgcn_fence(__ATOMIC_RELEASE, "agent"); asm volatile("s_waitcnt vmcnt(0) lgkmcnt(0)" ::: "memory"); grid.sync(); \
        __builtin_amdgcn_fence(__ATOMIC_ACQUIRE, "agent"); asm volatile("s_waitcnt vmcnt(0)" ::: "memory"); __syncthreads(); } while (0)
#define PH_END } if (lo <= ph && ph + 1 < hi) { if (lo < 0) grid.sync(); else { xcd_barrier(xbar); if (PROBE_REP & 128) xcd_barrier(xbar); } } ++ph;
    const float* MVL0 = X.MV; const float* MVC0 = X.MV + 9216; const float* MVL1 = X.MV + 2 * 9216; const float* MVC1 = X.MV + 3 * 9216;

    PH_BEGIN REPN(1) { __syncthreads(); phase_prep(X); } PH_END
#define FGEMM(EpiT, epi, Aptr, lda_, Btptr, rows, pm0_, N_, K_) { pg8::Gemm g_{Aptr, lda_, Btptr, K_, rows, N_, K_}; pg8::Order S_; S_.init(rows, N_, (int)gridDim.x, (int)blockIdx.x, pm0_); \
        const EpiT e_ = epi; pg8::gemm_phase<EpiT, pg8::Order, true, true>((PG8_LAS unsigned char*)lds, g_, S_, e_); }
#define NGEMM(site_, mode_, MVOFF_, SHOFF_, NGOFF_, FROM_IN_, MUL2_, ngbase_, Aptr, lda_, Btptr, K_) { pg8::Gemm g_{Aptr, lda_, Btptr, K_, NLAT, D, K_}; pg8::Order S_; S_.init(NLAT, D, (int)gridDim.x, (int)blockIdx.x, 1); \
        typedef EpiResidNorm<mode_, site_, MVOFF_, SHOFF_, NGOFF_, FROM_IN_, MUL2_> EN_; const EN_ e_{ws, ngbase_, X.x, X.out}; \
        pg8::gemm_phase<EN_, pg8::Order, false, true>((PG8_LAS unsigned char*)lds, g_, S_, e_); }
#define KSGEMM(Aptr, lda_, Btptr, ldb_, S_, kc_, mvc_, mul_) { pg8::Gemm g_{Aptr, lda_, Btptr, ldb_, 256, D, kc_}; pg8::OrderKS S2_; S2_.init(D, S_, kc_, (int)gridDim.x, (int)blockIdx.x); \
        const EpiPartial e_{X.CLOC, mvc_, mul_, kc_}; pg8::gemm_phase<EpiPartial, pg8::OrderKS, true, true>((PG8_LAS unsigned char*)lds, g_, S2_, e_); }
#define FFN_UP(idx, rows, pm0_) PH_BEGIN REPN(64) if (FASTG & 1) { FGEMM(EpiSwiGLU, (EpiSwiGLU{X.BIG}), X.XN, D, X.W13T + (size_t)(idx) * F2 * D, rows, pm0_, F2, D) \
            if (PREP_DEFER && (idx) < 3) { const int nwg_ = ((rows) / 256) * (F2 / 256), rem_ = nwg_ % (int)gridDim.x; \
                if (rem_ != 0 && (int)blockIdx.x >= rem_) prep_group(X, (idx) + 1, ((int)blockIdx.x - rem_) * NWAVES + X.wave, ((int)gridDim.x - rem_) * NWAVES); \
                else if (rem_ == 0) prep_group(X, (idx) + 1, X.gw, X.NGW); } } \
        else ngemm<true>(X, X.XN, D, X.W13T + (size_t)(idx) * F2 * D, D, (pm0_) * 256, rows, F2, FSwiglu{X.BIG}); PH_END
#define FFN_DOWN(idx, rows, pm0_, from_in, mvl_, mvc_, site_, mode_, MVOFF_, SHOFF_, NGOFF_, ngbase_) PH_BEGIN if (FASTG & 2) { \
            if (NFUSE) NGEMM(site_, mode_, MVOFF_, SHOFF_, NGOFF_, from_in, 1, ngbase_, X.BIG, FH, X.W2T + (size_t)(idx) * D * FH, FH) \
            else FGEMM(EpiResid, (EpiResid{(from_in) ? X.ctx : X.H, (from_in) ? X.x : X.H + (size_t)NCTX * D, X.H, mvl_, mvc_, 0.5f}), X.BIG, FH, X.W2T + (size_t)(idx) * D * FH, (KSPLIT ? NLAT : rows), (KSPLIT ? 1 : pm0_), D, FH) \
            if (KSPLIT && (pm0_) == 0) KSGEMM(X.BIG, FH, X.W2T + (size_t)(idx) * D * FH, FH, 11, 256, mvc_, 0.5f) \
            } \
        else ngemm<false>(X, X.BIG, FH, X.W2T + (size_t)(idx) * D * FH, FH, (pm0_) * 256, rows, D, FResid{&X, from_in, mvl_, mvc_, 0.5f}); PH_END
    PH_BEGIN REPN(2) phase_norm(X, 0, 0, true, 0); PH_END
    FFN_UP(0, R, 0)
    FFN_DOWN(0, R, 0, true, MVL0 + 2 * D, MVC0 + 2 * D, 0, 0, 2 * D, 3 * D, 1 * D, X.norm_g)
    PH_BEGIN phase_norm(X, 0, 1, false, 0, KSPLIT ? 11 : 0, NFUSE ? NCTX : R); PH_END
    if (FASTG & 4) {
        PH_BEGIN REPN(1024) FGEMM(EpiAB, (EpiAB{X.BIG, X.ab_gate_norm_g, X.ab_q_norm_g, X.ab_k_norm_g, X.ROPE}), X.XN, D, X.ABIN, R, 0, EVEN_IN, D) PH_END
    } else {
        PH_BEGIN ngemm<false>(X, X.XN, D, X.ABIN, D, 0, R, EVEN_IN, FRawAB{X.RAW}); PH_END
        PH_BEGIN phase_abpost(X); PH_END
    }
    PH_BEGIN REPN(4) { if (FASTM & 1) phase_sgu_fast(X, (lptr)lds); else phase_sgu_naive(X);
        __syncthreads();
        if (FASTA) phase_attn_fast(X, (char*)lds); else phase_attn_naive(X); } PH_END
    PH_BEGIN if (FASTG & 8) { if (NFUSE) NGEMM(1, 0, 5 * D, 6 * D, 2 * D, false, 2, X.norm_g, X.XN, D, X.ABOUT, D)
            else FGEMM(EpiResid, (EpiResid{X.H, X.H + (size_t)NCTX * D, X.H, MVL0 + 5 * D, MVC0 + 5 * D, 1.f}), X.XN, D, X.ABOUT, (KSPLIT ? NLAT : R), (KSPLIT ? 1 : 0), D, D)
            if (KSPLIT) KSGEMM(X.XN, D, X.ABOUT, D, 4, 256, MVC0 + 5 * D, 1.f) }
        else ngemm<false>(X, X.XN, D, X.ABOUT, D, 0, R, D, FResid{&X, false, MVL0 + 5 * D, MVC0 + 5 * D, 1.f}); PH_END
    PH_BEGIN phase_norm(X, 0, 2, false, 0, KSPLIT ? 4 : 0, NFUSE ? NCTX : R); PH_END
    FFN_UP(1, R, 0)
    FFN_DOWN(1, R, 0, false, MVL0 + 8 * D, MVC0 + 8 * D, 2, 0, 8 * D, 2 * 9216, 3 * D, X.norm_g)
    PH_BEGIN phase_norm(X, 1, 0, false, 0, KSPLIT ? 11 : 0, NFUSE ? NCTX : R); PH_END
    FFN_UP(2, R, 0)
    FFN_DOWN(2, R, 0, false, MVL1 + 2 * D, MVC1 + 2 * D, 3, 0, 2 * 9216 + 2 * D, 2 * 9216 + 3 * D, 4 * D, X.norm_g)
    PH_BEGIN phase_norm(X, 1, 1, false, 0, KSPLIT ? 11 : 0, NFUSE ? NCTX : R); PH_END
    PH_BEGIN REPN(1024) if (FASTG & 16) FGEMM(EpiML, (EpiML{X.BIG, X.G, X.ml_gate_b}), X.XN, D, X.MLIN, R, 0, ODD_PAD, D)
        else ngemm<false>(X, X.XN, D, X.MLIN, D, 0, R, ODD_PAD, FML{X.BIG, X.G, X.ml_gate_b}); PH_END
    PH_BEGIN REPN(8) phase_x1(X); PH_END
    for (int rr_ = 0; rr_ < ((PROBE_REP & 256) ? 2 : 1); ++rr_) {
    PH_BEGIN REPN(16) { if (FASTM & 2) phase_m1_fast(X, (lptr)lds); else phase_m1_naive(X); } PH_END
    PH_BEGIN phase_m2(X); PH_END
    }
    if (FASTM & 4) { PH_BEGIN REPN(32) phase_m3_fast(X, (lptr)lds); PH_END }
    else { PH_BEGIN phase_m3_naive(X); PH_END
    PH_BEGIN phase_m3post(X); PH_END }
    PH_BEGIN if (FASTG & 8) { if (NFUSE) NGEMM(4, 0, 2 * 9216 + 5 * D, 2 * 9216 + 6 * D, 5 * D, false, 2, X.norm_g, X.BIG, PMW, X.MLOUT, D)
            else FGEMM(EpiResid, (EpiResid{X.H, X.H + (size_t)NCTX * D, X.H, MVL1 + 5 * D, MVC1 + 5 * D, 1.f}), X.BIG, PMW, X.MLOUT, NLAT, 1, D, D) }
        else ngemm<false>(X, X.BIG, PMW, X.MLOUT, D, NCTX, NLAT, D, FResid{&X, false, MVL1 + 5 * D, MVC1 + 5 * D, 1.f}); PH_END
    if (!NFUSE) { PH_BEGIN REPN(2) phase_norm(X, 1, 2, false, NCTX); PH_END }
    FFN_UP(3, NLAT, 1)
    FFN_DOWN(3, NLAT, 1, false, MVL1 + 8 * D, MVC1 + 8 * D, 5, 1, 2 * 9216 + 8 * D, 0, 0, X.final_norm_g)
    if (!NFUSE) { PH_BEGIN phase_final(X); PH_END }
}
constexpr int N_PHASES = 27 - ((FASTG & 4) ? 1 : 0) - ((FASTM & 4) ? 1 : 0) + ((PROBE_REP & 256) ? 2 : 0) - (NFUSE ? 2 : 0);

extern "C" void kernel_launch(void* const* d_in, const int* in_sizes, int n_in, void* d_out, int out_size, void* d_ws, size_t ws_size, hipStream_t stream) {
    static int grid = 0;
    if (grid == 0) {
        if (n_in != 22 || ws_size < WS_RSS + WS_RSS_BYTES) { fprintf(stderr, "kernel_launch: unexpected n_in %d / ws_size %zu (need %zu)\n", n_in, ws_size, (size_t)WS_END); grid = -1; return; }
        int dev = 0, cus = 0, per_cu = 0;
        (void)hipGetDevice(&dev); (void)hipDeviceGetAttribute(&cus, hipDeviceAttributeMultiprocessorCount, dev);
        (void)hipFuncSetAttribute((const void*)fwd_kernel, hipFuncAttributeMaxDynamicSharedMemorySize, LDS_BYTES);
        (void)hipOccupancyMaxActiveBlocksPerMultiprocessor(&per_cu, (const void*)fwd_kernel, NTHR, LDS_BYTES);
        if (per_cu < 1) per_cu = 1;
        grid = cus * per_cu;
        (void)hipGetLastError();
    }
    if (grid < 0) return;
    (void)hipMemsetAsync((char*)d_ws + WS_BAR, 0, 48 * KiB, stream);
    if (NFUSE) (void)hipMemsetAsync((char*)d_ws + WS_RSS, 0, WS_RSS_BYTES, stream);
    Args a{};
    for (int i = 0; i < 22; ++i) a.in[i] = (const float*)d_in[i];
    a.out = (float*)d_out; a.ws = (unsigned char*)d_ws; a.ph_lo = 0; a.ph_hi = N_PHASES;
    void* kargs[] = {&a};
    hipError_t e = hipLaunchCooperativeKernel((const void*)fwd_kernel, dim3(grid), dim3(NTHR), kargs, LDS_BYTES, stream);
    if (e != hipSuccess) fprintf(stderr, "cooperative launch failed: %s (grid %d)\n", hipGetErrorString(e), grid);
}
```

```cpp
#include <hip/hip_runtime.h>
#include <hip/hip_cooperative_groups.h>
#include <cstdio>
#include <cstdint>
namespace cg = cooperative_groups;

typedef unsigned short u16;
typedef short bf16x8 __attribute__((ext_vector_type(8)));
typedef float f32x4 __attribute__((ext_vector_type(4)));
typedef unsigned u32x4 __attribute__((ext_vector_type(4)));
typedef unsigned u32x2 __attribute__((ext_vector_type(2)));
#define DEV __device__ __forceinline__

constexpr int D = 1024, NCTX = 256, NLAT = 16384, R = NCTX + NLAT;
constexpr int FH = 2816, F2 = 5632;
constexpr int EVEN_IN = 1792, ODD_IN = 3104, ODD_PAD = 3328, PMW = 3072;
constexpr int NPC = R / 128;
constexpr int NITEM = 2 * 8 * NPC;
constexpr float EPS = 1e-6f;
constexpr float C2 = 0.125f * 1.4426950408889634f;
constexpr int NWAVES = 8, NTHR = 512;
constexpr int LDS_BYTES = 147456;
#ifndef NFUSE
#define NFUSE 1
#endif
#ifndef FIXEDREF
#define FIXEDREF 1
#endif
#ifndef PREP_DEFER
#define PREP_DEFER 1
#endif
#ifndef KSPLIT
#define KSPLIT 1
#endif
#ifndef PROBE_REP
#define PROBE_REP 0
#endif
#define REPN(bit) for (int rep_ = 0; rep_ < ((PROBE_REP & (bit)) ? 2 : 1); ++rep_)
#ifndef FASTM
#define FASTM 7
#endif
#ifndef FASTA
#define FASTA 1
#endif
#ifndef FASTG
#define FASTG 31
#endif

constexpr size_t KiB = 1024, MiB = 1u << 20;
constexpr size_t WS_MV = 0;
constexpr size_t WS_BAR = 192 * KiB;
constexpr size_t WS_MISC = 256 * KiB;
constexpr size_t WS_GS = 1 * MiB;
constexpr size_t WS_G = 5 * MiB + 256 * KiB;
constexpr size_t WS_W13T = 7 * MiB + 512 * KiB;
constexpr size_t WS_W2T = WS_W13T + 44 * MiB;
constexpr size_t WS_ABIN = WS_W2T + 22 * MiB;
constexpr size_t WS_ABOUT = WS_ABIN + 3 * MiB + 512 * KiB;
constexpr size_t WS_MLIN = WS_ABOUT + 2 * MiB;
constexpr size_t WS_MLOUT = WS_MLIN + 6 * MiB + 512 * KiB;
constexpr size_t WS_SPW = WS_MLOUT + 2 * MiB;
constexpr size_t WS_H = WS_SPW + 256 * KiB;
constexpr size_t WS_XN = WS_H + 65 * MiB;
constexpr size_t WS_BIG = WS_XN + 32 * MiB + 512 * KiB;
constexpr size_t WS_CLOC = WS_BIG + 97 * MiB + 512 * KiB;
constexpr size_t WS_END = WS_CLOC + 65 * MiB;
constexpr size_t WS_RSS = WS_END;
constexpr size_t WS_RSS_BYTES = 6 * (size_t)16640 * 8;
static_assert(WS_RSS + WS_RSS_BYTES <= 352 * MiB, "ws map");

struct Args { const float* in[22]; float* out; unsigned char* ws; int ph_lo, ph_hi; };

DEV float bf2f(u16 v) { return __uint_as_float((unsigned)v << 16); }
DEV u16 f2bf(float f) { unsigned u = __float_as_uint(f); return (u16)((u + 0x7fffu + ((u >> 16) & 1u)) >> 16); }
DEV unsigned pk2(float lo, float hi) { return (unsigned)f2bf(lo) | ((unsigned)f2bf(hi) << 16); }
DEV float silu_f(float x) { return x / (1.f + __expf(-x)); }
DEV float sigmoid_f(float x) { return 1.f / (1.f + __expf(-x)); }
DEV float gelu_tanh(float x) { const float u = 0.7978845608028654f * (x + 0.044715f * x * x * x); return 0.5f * x * (1.f + tanhf(u)); }
DEV float log_sigmoid_f(float x) { return fminf(x, 0.f) - log1pf(__expf(-fabsf(x))); }
DEV float wave_sum(float v) {
#pragma unroll
    for (int o = 1; o < 64; o <<= 1) v += __shfl_xor(v, o);
    return v;
}
#define LDS_FENCE() asm volatile("s_waitcnt lgkmcnt(0)" ::: "memory")
DEV int tid_fresh() { int t = threadIdx.x; asm volatile("" : "+v"(t)); return t; }

struct Ctx {
    const float *x, *c, *ctx, *c_ctx, *mod_w, *mod_b, *norm_g, *ffn_w13, *ffn_w2, *ab_w_in, *ab_gate_norm_g, *ab_spatial_w, *ab_spatial_b,
        *ab_q_norm_g, *ab_k_norm_g, *ab_w_out, *ml_w_in, *ml_conv_w, *ml_gate_b, *ml_out_norm_g, *ml_w_out, *final_norm_g;
    float* out;
    float *ROPE, *MV, *MLOC, *BLAST, *MIN, *NLOC, *BB, *LI, *EE, *RM, *G, *H, *CLOC;
    u16 *W13T, *W2T, *ABIN, *ABOUT, *MLIN, *MLOUT, *SPW, *XN, *BIG, *RAW;
    int tid, lane, wave, gw, NGW, gtid, NT;
    unsigned char* lds;
};

DEV int maprow(int type, int n0) {
    if (type == 1) { if (n0 < FH) return 256 * (n0 / 128) + (n0 % 128); const int j = n0 - FH; return 256 * (j / 128) + 128 + (j % 128); }
    if (type == 2) { const int a = n0 % 256, wc = a / 64, bj = (a % 64) / 32; return (n0 / 256) * 256 + 128 * bj + 32 * wc; }
    return n0;
}
DEV void transpose_item(const float* W, int K, int N, u16* WT, int type, float* scr, int item, int lane) {
    const int nblk = N / 32, kb = item / nblk, nb = item % nblk, k0 = 64 * kb, n0 = 32 * nb;
#pragma unroll 8
    for (int i = 0; i < 32; ++i) { const int kk = 2 * i + (lane >> 5); scr[kk * 33 + (lane & 31)] = W[(size_t)(k0 + kk) * N + n0 + (lane & 31)]; }
    LDS_FENCE();
    const int c = lane & 7, d0 = maprow(type, n0);
#pragma unroll
    for (int j = 0; j < 4; ++j) {
        const int n = (lane >> 3) + 8 * j; const float* s = scr + (8 * c) * 33 + n;
        u32x4 o; o.x = pk2(s[0 * 33], s[1 * 33]); o.y = pk2(s[2 * 33], s[3 * 33]); o.z = pk2(s[4 * 33], s[5 * 33]); o.w = pk2(s[6 * 33], s[7 * 33]);
        *(u32x4*)(WT + (size_t)(d0 + n) * K + k0 + 8 * c) = o;
    }
    LDS_FENCE();
}
DEV void prep_group(const Ctx& X, int grp, int widx, int nworkers) {
    float* scr = (float*)(X.lds) + X.wave * (64 * 33);
    constexpr int I13 = 16 * (F2 / 32), I2 = (FH / 64) * 32, IABI = 16 * (EVEN_IN / 32), ISQ = 16 * 32, IMLI = 16 * (ODD_IN / 32);
    const int fi = grp == 0 ? 0 : grp;
    const int nit = I13 + I2 + (grp == 1 ? IABI + ISQ : (grp == 2 ? IMLI + ISQ : 0));
    for (int it = widx; it < nit; it += nworkers) {
        int r = it;
        if (r < I13) { transpose_item(X.ffn_w13 + (size_t)fi * D * F2, D, F2, X.W13T + (size_t)fi * F2 * D, 1, scr, r, X.lane); continue; } r -= I13;
        if (r < I2) { transpose_item(X.ffn_w2 + (size_t)fi * FH * D, FH, D, X.W2T + (size_t)fi * D * FH, 0, scr, r, X.lane); continue; } r -= I2;
        if (grp == 1) { if (r < IABI) { transpose_item(X.ab_w_in, D, EVEN_IN, X.ABIN, 2, scr, r, X.lane); continue; } r -= IABI; transpose_item(X.ab_w_out, D, D, X.ABOUT, 0, scr, r, X.lane); }
        else { if (r < IMLI) { transpose_item(X.ml_w_in, D, ODD_IN, X.MLIN, 0, scr, r, X.lane); continue; } r -= IMLI; transpose_item(X.ml_w_out, D, D, X.MLOUT, 0, scr, r, X.lane); }
    }
}
DEV void phase_prep(Ctx& X) {
    if (PREP_DEFER) prep_group(X, 0, X.gw, X.NGW);
    else for (int g = 0; g < 4; ++g) prep_group(X, g, X.gw, X.NGW);
    for (int i = X.gtid; i < (ODD_PAD - ODD_IN) * D / 8; i += X.NT) *(u32x4*)(X.MLIN + (size_t)ODD_IN * D + (size_t)i * 8) = (u32x4){0u, 0u, 0u, 0u};
    for (int i = X.gtid; i < 8 * 128 * 128 / 4; i += X.NT) { const f32x4 v = *(const f32x4*)(X.ab_spatial_w + (size_t)i * 4); u32x2 o; o.x = pk2(v.x, v.y); o.y = pk2(v.z, v.w); *(u32x2*)(X.SPW + (size_t)i * 4) = o; }
    for (int i = X.gtid; i < 256 * 16; i += X.NT) { const int pos = i >> 4, k = i & 15; const float ang = (float)pos * powf(10000.f, -(float)(2 * k) / 32.f); X.ROPE[pos * 32 + k] = cosf(ang); X.ROPE[pos * 32 + 16 + k] = sinf(ang); }
    __syncthreads();
    float* sS = (float*)X.lds;
    float* red = sS + 2048;
    for (int i = X.tid; i < 1024; i += NTHR) { sS[i] = silu_f(X.c[i]); sS[1024 + i] = silu_f(X.c_ctx[i]); }
    __syncthreads();
    for (int it = blockIdx.x; it < 2 * 288; it += gridDim.x) {
        const int l = it / 288, cg0 = (it % 288) * 32, col = cg0 + (X.tid & 31), ks = X.tid >> 5;
        const float* w = X.mod_w + (size_t)l * D * 9216 + (size_t)(ks * 64) * 9216 + col;
        float a0 = 0.f, a1 = 0.f;
#pragma unroll 8
        for (int k = 0; k < 64; ++k) { const float wv = w[(size_t)k * 9216]; a0 += sS[ks * 64 + k] * wv; a1 += sS[1024 + ks * 64 + k] * wv; }
        red[(ks * 32 + (X.tid & 31)) * 2] = a0; red[(ks * 32 + (X.tid & 31)) * 2 + 1] = a1;
        __syncthreads();
        if (X.tid < 64) {
            const int cc = X.tid & 31, w2 = X.tid >> 5; float s = 0.f;
            for (int k = 0; k < 16; ++k) s += red[(k * 32 + cc) * 2 + w2];
            X.MV[(size_t)(l * 2 + w2) * 9216 + cg0 + cc] = s + X.mod_b[(size_t)l * 9216 + cg0 + cc];
        }
        __syncthreads();
    }
}

DEV const float* row_src(const Ctx& X, bool from_in, int r) { return from_in ? (r < NCTX ? X.ctx + (size_t)r * D : X.x + (size_t)(r - NCTX) * D) : X.H + (size_t)r * D; }
DEV void phase_norm(Ctx& X, int l, int i, bool from_in, int r_lo, int nks = 0, int r_hi = R) {
    const float* g = X.norm_g + (size_t)(l * 3 + i) * D;
    for (int r = r_lo + X.gw; r < r_hi; r += X.NGW) {
        const f32x4* xr = (const f32x4*)row_src(X, from_in, r) + X.lane;
        const float* mv = X.MV + (size_t)(l * 2 + (r < NCTX ? 1 : 0)) * 9216 + (size_t)(3 * i) * D;
        f32x4 v[4]; float s = 0.f;
#pragma unroll
        for (int j = 0; j < 4; ++j) v[j] = xr[64 * j];
        const bool addp = nks > 0 && r < NCTX;
        if (addp) for (int k = 0; k < nks; ++k) { const f32x4* pr = (const f32x4*)(X.CLOC + ((size_t)k * 256 + r) * D) + X.lane;
#pragma unroll
            for (int j = 0; j < 4; ++j) v[j] = v[j] + pr[64 * j]; }
#pragma unroll
        for (int j = 0; j < 4; ++j) s += (v[j].x * v[j].x + v[j].y * v[j].y) + (v[j].z * v[j].z + v[j].w * v[j].w);
        const float rs = rsqrtf(wave_sum(s) * (1.f / D) + EPS);
        if ((from_in && r < NCTX) || addp) { f32x4* hr = (f32x4*)(X.H + (size_t)r * D) + X.lane;
#pragma unroll
            for (int j = 0; j < 4; ++j) hr[64 * j] = v[j]; }
        u32x2* o = (u32x2*)(X.XN + (size_t)r * D) + X.lane;
#pragma unroll
        for (int j = 0; j < 4; ++j) {
            const int c = 4 * X.lane + 256 * j;
            const f32x4 gg = *(const f32x4*)(g + c), sh = *(const f32x4*)(mv + c), sc = *(const f32x4*)(mv + D + c);
            f32x4 y = v[j] * rs * gg * (sc + 1.f) + sh;
            u32x2 w; w.x = pk2(y.x, y.y); w.y = pk2(y.z, y.w); o[64 * j] = w;
        }
    }
}
DEV void phase_final(Ctx& X) {
    for (int t = X.gw; t < NLAT; t += X.NGW) {
        const f32x4* xr = (const f32x4*)(X.H + (size_t)(NCTX + t) * D) + X.lane;
        f32x4 v[4]; float s = 0.f;
#pragma unroll
        for (int j = 0; j < 4; ++j) { v[j] = xr[64 * j]; s += (v[j].x * v[j].x + v[j].y * v[j].y) + (v[j].z * v[j].z + v[j].w * v[j].w); }
        const float rs = rsqrtf(wave_sum(s) * (1.f / D) + EPS);
        f32x4* o = (f32x4*)(X.out + (size_t)t * D) + X.lane;
#pragma unroll
        for (int j = 0; j < 4; ++j) { const f32x4 gg = *(const f32x4*)(X.final_norm_g + 4 * X.lane + 256 * j); o[64 * j] = v[j] * rs * gg; }
    }
}

template <bool DUAL, class F>
DEV void ngemm(const Ctx& X, const u16* A, int lda, const u16* Bt, int K, int row0, int nrows, int ncols_tile, const F& f) {
    const int nrt = nrows / 32, spu = DUAL ? 4 : 8, nslots = (ncols_tile / 256) * spu, fr = X.lane & 15, fq = X.lane >> 4;
    for (long it = X.gw; it < (long)nrt * nslots; it += X.NGW) {
        const int rt = (int)(it % nrt), sl = (int)(it / nrt), u = sl / spu, s = sl % spu, n0 = u * 256 + 32 * s, r0 = row0 + rt * 32;
        f32x4 acc[2][2], acc2[2][2];
#pragma unroll
        for (int m = 0; m < 2; ++m)
#pragma unroll
            for (int n = 0; n < 2; ++n) { acc[m][n] = (f32x4){0.f, 0.f, 0.f, 0.f}; acc2[m][n] = (f32x4){0.f, 0.f, 0.f, 0.f}; }
        const u16* a0 = A + (size_t)(r0 + fr) * lda + fq * 8;
        const u16* b0 = Bt + (size_t)(n0 + fr) * K + fq * 8;
        for (int k = 0; k < K; k += 32) {
            bf16x8 a[2], b[2], c[2];
            a[0] = *(const bf16x8*)(a0 + k); a[1] = *(const bf16x8*)(a0 + (size_t)16 * lda + k);
            b[0] = *(const bf16x8*)(b0 + k); b[1] = *(const bf16x8*)(b0 + (size_t)16 * K + k);
            if (DUAL) { c[0] = *(const bf16x8*)(b0 + (size_t)128 * K + k); c[1] = *(const bf16x8*)(b0 + (size_t)144 * K + k); }
#pragma unroll
            for (int m = 0; m < 2; ++m)
#pragma unroll
                for (int n = 0; n < 2; ++n) {
                    acc[m][n] = __builtin_amdgcn_mfma_f32_16x16x32_bf16(a[m], b[n], acc[m][n], 0, 0, 0);
                    if (DUAL) acc2[m][n] = __builtin_amdgcn_mfma_f32_16x16x32_bf16(a[m], c[n], acc2[m][n], 0, 0, 0);
                }
        }
#pragma unroll
        for (int m = 0; m < 2; ++m)
#pragma unroll
            for (int n = 0; n < 2; ++n)
#pragma unroll
                for (int j = 0; j < 4; ++j) f(r0 + 16 * m + 4 * fq + j, n0 + 16 * n + fr, acc[m][n][j], acc2[m][n][j]);
    }
}
struct FSwiglu { u16* HID; DEV void operator()(int r, int p, float g, float u) const { const int col = 128 * (p / 256) + (p % 256); HID[(size_t)r * FH + col] = f2bf(silu_f(g) * u); } };
struct FResid { const Ctx* X; bool from_in; const float* mvl; const float* mvc; float mul;
    DEV void operator()(int r, int c, float v, float) const { const float b = row_src(*X, from_in, r)[c]; const float m = (r < NCTX ? mvc : mvl)[c]; X->H[(size_t)r * D + c] = b + mul * m * v; } };
struct FRawAB { u16* RAW; DEV void operator()(int r, int p, float v, float) const { const int q = p % 256, bj = q / 128, wc = (q % 128) / 32, x = q % 32; RAW[(size_t)r * EVEN_IN + (p / 256) * 256 + 64 * wc + 32 * bj + x] = f2bf(v); } };
struct FML { u16* PM; float* G; const float* gb; DEV void operator()(int r, int c, float v, float) const { if (c < PMW) PM[(size_t)r * PMW + c] = f2bf(v); else if (c < ODD_IN) G[(size_t)r * 32 + (c - PMW)] = v + gb[c - PMW]; } };

DEV void phase_abpost(Ctx& X) {
    u16* P0 = X.BIG;
    for (int it = X.gtid; it < R * 28; it += X.NT) {
        const int r = it / 28, grp = it % 28, c0 = grp * 64;
        const u16* src = X.RAW + (size_t)r * EVEN_IN + c0; u16* dst = P0 + (size_t)r * EVEN_IN + c0;
        if (grp < 8) { for (int d = 0; d < 64; ++d) dst[d] = f2bf(gelu_tanh(bf2f(src[d]))); continue; }
        if (grp >= 26) { for (int d = 0; d < 64; ++d) dst[d] = src[d]; continue; }
        float ss = 0.f;
        if (grp < 16) { for (int d = 0; d < 64; ++d) { const float v = gelu_tanh(bf2f(src[d])); ss += v * v; } const float rs = rsqrtf(ss * (1.f / 64) + EPS);
            for (int d = 0; d < 64; ++d) dst[d] = f2bf(gelu_tanh(bf2f(src[d])) * rs * X.ab_gate_norm_g[c0 - 512 + d]); continue; }
        for (int d = 0; d < 64; ++d) { const float v = bf2f(src[d]); ss += v * v; }
        const float rs = rsqrtf(ss * (1.f / 64) + EPS); const bool isq = grp < 24; const float* g = isq ? X.ab_q_norm_g : X.ab_k_norm_g; const float osc = isq ? C2 : 1.f;
        if (r < NCTX) { for (int d = 0; d < 64; ++d) dst[d] = f2bf(bf2f(src[d]) * rs * g[d] * osc); continue; }
        const int t = r - NCTX; const float pr = (float)(t / 64), pc = (float)(t % 64);
        for (int half = 0; half < 2; ++half) for (int i = 0; i < 16; ++i) {
            const float invf = __powf(10000.f, -(float)(2 * i) / 32.f), ang = (half ? pc : pr) * invf, cs = cosf(ang), sn = sinf(ang);
            const int d1 = half * 32 + i, d2 = d1 + 16; const float x1 = bf2f(src[d1]) * rs * g[d1], x2 = bf2f(src[d2]) * rs * g[d2];
            dst[d1] = f2bf((x1 * cs - x2 * sn) * osc); dst[d2] = f2bf((x2 * cs + x1 * sn) * osc);
        }
    }
}
DEV void phase_sgu_naive(Ctx& X) {
    const u16* P0 = X.BIG; u16* CAT = X.XN;
    for (int it = X.gtid; it < R * 512; it += X.NT) {
        const int r = it / 512, col = it % 512, ch = r / 128, t = r % 128, g = col / 64;
        const float* w = X.ab_spatial_w + (size_t)(g * 128 + t) * 128; float s = X.ab_spatial_b[g * 128 + t];
        for (int sp = 0; sp < 128; ++sp) s += w[sp] * bf2f(P0[(size_t)(ch * 128 + sp) * EVEN_IN + 512 + col]);
        CAT[(size_t)r * D + col] = f2bf(bf2f(P0[(size_t)r * EVEN_IN + col]) * s);
    }
}
DEV void phase_attn_naive(Ctx& X) {
    const u16* P0 = X.BIG; u16* CAT = X.XN;
    for (int it = X.gtid; it < R * 8; it += X.NT) {
        const int h = __builtin_amdgcn_readfirstlane(it / R), r = it % R, kvh = h / 4;
        const int nkeys = __builtin_amdgcn_readfirstlane(r < NCTX ? NCTX : R);
        float q[64], acc[64];
        for (int d = 0; d < 64; ++d) { q[d] = bf2f(P0[(size_t)r * EVEN_IN + 1024 + h * 64 + d]); acc[d] = 0.f; }
        float m = -1e30f, l = 0.f;
        for (int key = 0; key < nkeys; ++key) {
            const u16* kp = P0 + (size_t)key * EVEN_IN + 1536 + kvh * 64; const u16* vp = kp + 128;
            float s = 0.f;
#pragma unroll
            for (int d = 0; d < 64; ++d) s += q[d] * bf2f(kp[d]);
            if (s > m) { const float f = exp2f(m - s); l *= f;
#pragma unroll
                for (int d = 0; d < 64; ++d) acc[d] *= f;
                m = s; }
            const float p = exp2f(s - m); l += p;
#pragma unroll
            for (int d = 0; d < 64; ++d) acc[d] += p * bf2f(vp[d]);
        }
        const float il = 1.f / l;
        for (int d = 0; d < 64; ++d) CAT[(size_t)r * D + 512 + h * 64 + d] = f2bf(acc[d] * il);
    }
}

DEV int item_of(int d, int h, int pc) { return (d * 8 + h) * NPC + pc; }
DEV void phase_x1(Ctx& X) {
    const u16* PM = X.BIG; u16* QKC = X.XN;
    for (int it = X.gtid; it < R * 128; it += X.NT) {
        const int r = it / 128, c0 = (it % 128) * 8;
        const bool hp = (r != 0 && r != NCTX), hn = (r != NCTX - 1 && r != R - 1);
        const u16* p1 = PM + (size_t)r * PMW + c0;
        const bf16x8 z = (bf16x8){0, 0, 0, 0, 0, 0, 0, 0};
        const bf16x8 v1 = *(const bf16x8*)p1, v0 = hp ? *(const bf16x8*)(p1 - PMW) : z, v2 = hn ? *(const bf16x8*)(p1 + PMW) : z;
        const float sc = c0 < 512 ? 0.125f : 1.f; float y[8];
#pragma unroll
        for (int j = 0; j < 8; ++j) { const float a = X.ml_conv_w[c0 + j] * bf2f((u16)v0[j]) + X.ml_conv_w[1024 + c0 + j] * bf2f((u16)v1[j]) + X.ml_conv_w[2048 + c0 + j] * bf2f((u16)v2[j]); y[j] = silu_f(a) * sc; }
        u32x4 o; o.x = pk2(y[0], y[1]); o.y = pk2(y[2], y[3]); o.z = pk2(y[4], y[5]); o.w = pk2(y[6], y[7]);
        *(u32x4*)(QKC + (size_t)r * D + c0) = o;
    }
    for (int it = X.gw; it < NITEM; it += X.NGW) {
        const int d = it / (8 * NPC), h = (it / NPC) % 8, pc = it % NPC, lane = X.lane;
        const int pf = d == 0 ? 2 * lane : 2 * lane + 1, ps = d == 0 ? 2 * lane + 1 : 2 * lane;
        const float* g0 = X.G + (size_t)(pc * 128) * 32;
        const float lif = g0[pf * 32 + (2 * d) * 8 + h], lis = g0[ps * 32 + (2 * d) * 8 + h];
        const float lff = log_sigmoid_f(g0[pf * 32 + (2 * d + 1) * 8 + h]), lfs = log_sigmoid_f(g0[ps * 32 + (2 * d + 1) * 8 + h]);
        float P = lff + lfs;
#pragma unroll
        for (int o = 1; o < 64; o <<= 1) { const float t = d == 0 ? __shfl_up(P, o) : __shfl_down(P, o); const bool ok = d == 0 ? (lane >= o) : (lane + o < 64); if (ok) P += t; }
        const float total = __shfl(P, d == 0 ? 63 : 0);
        const float Cs = P, Cf = P - lfs;
        const float xf = lif - Cf, xs = lis - Cs;
        float M = fmaxf(xf, xs);
#pragma unroll
        for (int o = 1; o < 64; o <<= 1) { const float t = d == 0 ? __shfl_up(M, o) : __shfl_down(M, o); const bool ok = d == 0 ? (lane >= o) : (lane + o < 64); if (ok) M = fmaxf(M, t); }
        float ex = d == 0 ? __shfl_up(M, 1) : __shfl_down(M, 1); if (d == 0 ? lane == 0 : lane == 63) ex = -INFINITY;
        const float rmf = fmaxf(ex, xf), rms = fmaxf(rmf, xs);
        const float wf = total - Cf + lif, ws = total - Cs + lis;
        float mw = fmaxf(wf, ws);
#pragma unroll
        for (int o = 1; o < 64; o <<= 1) mw = fmaxf(mw, __shfl_xor(mw, o));
        float* bb = X.BB + (size_t)it * 128; float* li = X.LI + (size_t)it * 128; float* ee = X.EE + (size_t)it * 128; float* rm = X.RM + (size_t)it * 128;
        bb[pf] = Cf; bb[ps] = Cs; li[pf] = lif; li[ps] = lis; ee[pf] = __expf(wf - mw); ee[ps] = __expf(ws - mw); rm[pf] = rmf; rm[ps] = rms;
        if (lane == 0) { X.MLOC[it] = mw; X.BLAST[it] = total; }
    }
}
DEV void phase_m1_naive(Ctx& X) {
    const u16* PM = X.BIG; const u16* QKC = X.XN;
    for (long it = X.gtid; it < (long)NITEM * 8192; it += X.NT) {
        const int item = (int)(it / 8192), e = (int)(it % 8192), vv = e / 64, kk = e % 64, h = (item / NPC) % 8, pc = item % NPC;
        const float* ee = X.EE + (size_t)item * 128; float s = 0.f, sn = 0.f;
        for (int p = 0; p < 128; ++p) { const size_t row = (size_t)pc * 128 + p; const float kv = bf2f(QKC[row * D + 512 + h * 64 + kk]) * ee[p]; sn += kv; s += kv * bf2f(PM[row * PMW + 1024 + h * 128 + vv]); }
        X.CLOC[(size_t)item * 8192 + e] = s; if (vv == 0) X.NLOC[(size_t)item * 64 + kk] = sn;
    }
}
DEV int scan_pc(int d, int n) { return d == 0 ? n : (n == 0 ? 1 : (n == 1 ? 0 : 131 - n)); }
DEV void phase_m2(Ctx& X) {
    for (int it = X.gtid; it < 16 * 8192; it += X.NT) {
        const int dh = it >> 13, e = it & 8191; const bool hasn = e < 64;
        float* cb = X.CLOC + e; float* nb = X.NLOC + (hasn ? e : 0);
        float C = 0.f, Nn = 0.f, m = 0.f;
        float cl[13], nl[13], bl[13], ml[13]; int itm[13];
#define M2_LOAD(n0) _Pragma("unroll") for (int i = 0; i < 13; ++i) { itm[i] = dh * NPC + scan_pc(dh >> 3, (n0) + i); cl[i] = cb[(size_t)itm[i] * 8192]; nl[i] = hasn ? nb[(size_t)itm[i] * 64] : 0.f; bl[i] = X.BLAST[itm[i]]; ml[i] = X.MLOC[itm[i]]; }
        M2_LOAD(0)
#pragma unroll 1
        for (int n0 = 0; n0 < NPC; n0 += 13) {
            float ccl[13], cnl[13], cbl[13], cml[13]; int citm[13];
#pragma unroll
            for (int i = 0; i < 13; ++i) { ccl[i] = cl[i]; cnl[i] = nl[i]; cbl[i] = bl[i]; cml[i] = ml[i]; citm[i] = itm[i]; }
            if (n0 + 13 < NPC) { M2_LOAD(n0 + 13) }
#pragma unroll
            for (int i = 0; i < 13; ++i) {
                const float mn = fmaxf(cbl[i] + m, cml[i]), a = __expf(cbl[i] + m - mn), g = __expf(cml[i] - mn);
                cb[(size_t)citm[i] * 8192] = C; if (hasn) nb[(size_t)citm[i] * 64] = Nn; if (e == 0) X.MIN[citm[i]] = m;
                C = a * C + g * ccl[i]; Nn = a * Nn + g * cnl[i]; m = mn;
            }
        }
#undef M2_LOAD
    }
}
DEV void phase_m3_naive(Ctx& X) {
    u16* PM = X.BIG; const u16* QKC = X.XN;
    for (int it = X.gtid; it < 8 * 4 * NLAT; it += X.NT) {
        const int t = it % NLAT, hv = __builtin_amdgcn_readfirstlane(it / NLAT), h = hv / 4, vq = hv % 4, r = NCTX + t;
        const int pc = __builtin_amdgcn_readfirstlane(r / 128), j = r % 128;
        float q[64]; for (int k = 0; k < 64; ++k) q[k] = bf2f(QKC[(size_t)r * D + h * 64 + k]);
        float hacc[32]; for (int v = 0; v < 32; ++v) hacc[v] = 0.f;
        for (int d = 0; d < 2; ++d) {
            const int item = item_of(d, h, pc);
            const float* bb = X.BB + (size_t)item * 128; const float* li = X.LI + (size_t)item * 128;
            const float Bj = bb[j], m_in = X.MIN[item], mrow = Bj + fmaxf(m_in, X.RM[(size_t)item * 128 + j]), a = __expf(Bj + m_in - mrow);
            float num[32], den = 0.f;
            const float* cin = X.CLOC + (size_t)item * 8192 + (size_t)(vq * 32) * 64; const float* nin = X.NLOC + (size_t)item * 64;
            for (int k = 0; k < 64; ++k) den += nin[k] * q[k];
            den *= a;
            for (int v = 0; v < 32; ++v) { float s = 0.f; for (int k = 0; k < 64; ++k) s += cin[v * 64 + k] * q[k]; num[v] = a * s; }
            for (int s = 0; s < 128; ++s) {
                const bool valid = d == 0 ? (s <= j) : (s >= j);
                const size_t row = (size_t)pc * 128 + s; const u16* kp = QKC + row * D + 512 + h * 64; const u16* vp = PM + row * PMW + 1024 + h * 128 + vq * 32;
                float sc = 0.f;
#pragma unroll
                for (int k = 0; k < 64; ++k) sc += q[k] * bf2f(kp[k]);
                const float w = valid ? __expf(Bj - bb[s] + li[s] - mrow) : 0.f; sc *= w; den += sc;
#pragma unroll
                for (int v = 0; v < 32; ++v) num[v] += sc * bf2f(vp[v]);
            }
            const float inv = 1.f / fmaxf(fabsf(den), __expf(-mrow));
            for (int v = 0; v < 32; ++v) hacc[v] += num[v] * inv;
        }
        for (int v = 0; v < 32; ++v) PM[(size_t)r * PMW + h * 128 + vq * 32 + v] = f2bf(hacc[v]);
    }
}
DEV void phase_m3post(Ctx& X) {
    u16* PM = X.BIG;
    for (int it = X.gtid; it < 8 * NLAT; it += X.NT) {
        const int t = it % NLAT, h = it / NLAT; u16* p = PM + (size_t)(NCTX + t) * PMW + h * 128; const u16* o = p + 2048;
        float ss = 0.f; for (int v = 0; v < 128; ++v) { const float x = bf2f(p[v]); ss += x * x; }
        const float rs = rsqrtf(ss * (1.f / 128) + EPS);
        for (int v = 0; v < 128; ++v) p[v] = f2bf(bf2f(p[v]) * rs * X.ml_out_norm_g[h * 128 + v] * sigmoid_f(bf2f(o[v])));
    }
}

namespace pg8 {
#define PG8_LAS __attribute__((address_space(3)))
typedef unsigned short bf16_t;
typedef short bf16x8 __attribute__((ext_vector_type(8)));
typedef float f32x4 __attribute__((ext_vector_type(4)));
typedef unsigned u32x4 __attribute__((ext_vector_type(4)));
constexpr int BM = 256, BK = 64, HALF = 128, HTB = HALF * BK * 2  , STAGE_BYTES = 8 * HTB, NXCD = 8, WGM = 4;

__host__ __device__ __forceinline__ int lds_byte(int r, int c) { const int st = (r >> 4) * 2 + (c >> 5), rr = r & 15, cc = c & 31, ob = rr * 64 + cc * 2; return st * 1024 + (ob ^ (((ob >> 9) & 1) << 5)); }
__host__ __device__ __forceinline__ void stage_rc(int b, int& R, int& C) { const int st = b / 1024, sb = b % 1024, swz = sb ^ (((sb >> 9) & 1) << 5); R = (st >> 1) * 16 + swz / 64; C = (st & 1) * 32 + (swz % 64) / 2; }
__host__ __device__ __forceinline__ int perm32(int rho) { const int n = rho >> 4, i = rho & 15; return 8 * (i >> 2) + 4 * n + (i & 3); }

struct Unit { int pm, pn, ko; };
struct Gemm { const bf16_t* A; int lda; const bf16_t* Bt; int ldb; int M, N, K; };
struct Order {
    int nM, nN, nwg, G, c, pm0;
    __device__ void init(int M, int N, int G_, int c_, int pm0_) { nM = M / BM; nN = N / BM; nwg = nM * nN; G = G_; c = c_; pm0 = pm0_; }
    __device__ bool next(int i, Unit& u) const {
        const long L = (long)i * G + c; if (L >= nwg) return false;
        int wgid = (int)L; { const int q = nwg / NXCD, r = nwg % NXCD, xcd = wgid % NXCD, off = wgid / NXCD; wgid = (xcd < r ? xcd * (q + 1) : r * (q + 1) + (xcd - r) * q) + off; }
        const int nig = WGM * nN, gid = wgid / nig, fm = gid * WGM, gsz = (nM - fm) < WGM ? (nM - fm) : WGM;
        u.pm = pm0 + fm + ((wgid % nig) % gsz); u.pn = (wgid % nig) / gsz; u.ko = 0; return true;
    }
    __device__ __forceinline__ void a_ready(const Unit&) const {}
    __device__ __forceinline__ void done(const Unit&) const {}
};
struct OrderKS {
    int nN, nwg, G, c, kc;
    __device__ void init(int N, int S, int kc_, int G_, int c_) { nN = N / BM; nwg = nN * S; G = G_; c = c_; kc = kc_; }
    __device__ bool next(int i, Unit& u) const { const long L = (long)i * G + c; if (L >= nwg) return false; u.pm = 0; u.pn = (int)L % nN; u.ko = ((int)L / nN) * kc; return true; }
    __device__ __forceinline__ void a_ready(const Unit&) const {}
    __device__ __forceinline__ void done(const Unit&) const {}
};

template <class Epi, class Sched, bool ALIGN_EPI = false, bool SP2 = false>
__device__ __forceinline__ void gemm_phase(PG8_LAS unsigned char* lds, const Gemm g, const Sched& S, const Epi& E) {
    const int tid = tid_fresh(), wid = __builtin_amdgcn_readfirstlane(tid >> 6), lane = tid & 63, wr = wid >> 2, wc = wid & 3, fr = lane & 15, fq = lane >> 4;
    const int K = g.K, nt = K / BK;
    unsigned voffA[2], voffB[2];
#pragma unroll
    for (int i = 0; i < 2; ++i) { int R, C; stage_rc(tid * 16 + i * 8192, R, C); const int Rb = Epi::PERM ? ((R & ~31) + perm32(R & 31)) : R;
        voffA[i] = (unsigned)(R * g.lda + C) * 2u; voffB[i] = (unsigned)(Rb * g.ldb + C) * 2u; }
    const size_t kstep = (size_t)(BK * 2);
    const size_t hstepA = (size_t)HALF * g.lda * 2, hstepB = (size_t)HALF * g.ldb * 2;
    const size_t tstepA = 2 * hstepA, tstepB = 2 * hstepB;
    const unsigned ldsw = (unsigned)wid * 1024u;
    const int aoff = lds_byte(wr * 64 + fr, fq * 8), boff = lds_byte(wc * 32 + fr, fq * 8);
#define PG8_SA(b, h) (((b) * 2 + (h)) * HTB)
#define PG8_SB(b, h) ((4 + (b) * 2 + (h)) * HTB)
#define PG8_STAGE(bufoff, gbase, voff) do { _Pragma("unroll") for (int _i = 0; _i < 2; ++_i) \
        __builtin_amdgcn_global_load_lds((const unsigned*)((const char*)(gbase) + (voff)[_i]), (PG8_LAS unsigned*)(lds + (bufoff) + ldsw + _i * 8192), 16, 0, 0); } while (0)
#define PG8_LDA(dst, b, h) do { _Pragma("unroll") for (int m = 0; m < 4; ++m) _Pragma("unroll") for (int k = 0; k < 2; ++k) dst[m][k] = *(const PG8_LAS bf16x8*)(lds + PG8_SA(b, h) + aoff + m * 2048 + k * 1024); } while (0)
#define PG8_LDB(dst, b, h) do { _Pragma("unroll") for (int n = 0; n < 2; ++n) _Pragma("unroll") for (int k = 0; k < 2; ++k) dst[n][k] = *(const PG8_LAS bf16x8*)(lds + PG8_SB(b, h) + boff + n * 2048 + k * 1024); } while (0)
#define PG8_MMA(ai, bj, At, Bt) do { __builtin_amdgcn_s_setprio(1); _Pragma("unroll") for (int m = 0; m < 4; ++m) _Pragma("unroll") for (int n = 0; n < 2; ++n) _Pragma("unroll") for (int k = 0; k < 2; ++k) \
        acc[ai][bj][m][n] = __builtin_amdgcn_mfma_f32_16x16x32_bf16(Bt[n][k], At[m][k], acc[ai][bj][m][n], 0, 0, 0); __builtin_amdgcn_s_setprio(0); } while (0)
#define PG8_WAIT_V(n) asm volatile("s_waitcnt vmcnt(" #n ")" ::: "memory")
#define PG8_WAIT_L(n) asm volatile("s_waitcnt lgkmcnt(" #n ")" ::: "memory")
#define PG8_BAR __builtin_amdgcn_s_barrier()
#define PG8_SCHED __builtin_amdgcn_sched_barrier(0)
    Unit cur, nxt; int ui = 0;
    if (!S.next(0, cur)) return;
    f32x4 acc[2][2][4][2];
#pragma unroll
    for (int a = 0; a < 2; ++a)
#pragma unroll
        for (int b = 0; b < 2; ++b)
#pragma unroll
            for (int m = 0; m < 4; ++m)
#pragma unroll
                for (int n = 0; n < 2; ++n) acc[a][b][m][n] = (f32x4){0.f, 0.f, 0.f, 0.f};
    bf16x8 At[4][2], B0[2][2], B1[2][2];
    const char* cA = (const char*)g.A + (size_t)cur.pm * tstepA + (size_t)cur.ko * 2; const char* cB = (const char*)g.Bt + (size_t)cur.pn * tstepB + (size_t)cur.ko * 2;
    S.a_ready(cur);
    if constexpr (SP2) {
        PG8_STAGE(PG8_SB(0, 0), cB, voffB); PG8_STAGE(PG8_SB(0, 1), cB + hstepB, voffB); PG8_STAGE(PG8_SA(0, 0), cA, voffA); PG8_STAGE(PG8_SA(0, 1), cA + hstepA, voffA);
        if (wr == 1) PG8_BAR;
        PG8_WAIT_V(2); PG8_BAR;
        PG8_STAGE(PG8_SB(1, 0), cB + kstep, voffB); PG8_STAGE(PG8_SA(1, 0), cA + kstep, voffA); PG8_STAGE(PG8_SB(1, 1), cB + hstepB + kstep, voffB);
        PG8_WAIT_V(6); PG8_BAR;
    } else {
        PG8_STAGE(PG8_SB(0, 0), cB, voffB); PG8_STAGE(PG8_SA(0, 0), cA, voffA); PG8_STAGE(PG8_SB(0, 1), cB + hstepB, voffB); PG8_STAGE(PG8_SA(0, 1), cA + hstepA, voffA);
        if (wr == 1) PG8_BAR;
        PG8_WAIT_V(4); PG8_BAR;
        PG8_STAGE(PG8_SB(1, 0), cB + kstep, voffB); PG8_STAGE(PG8_SA(1, 0), cA + kstep, voffA); PG8_STAGE(PG8_SB(1, 1), cB + hstepB + kstep, voffB);
        PG8_WAIT_V(6); PG8_BAR;
    }
    for (;;) {
        const bool has_next = S.next(ui + 1, nxt);
        const char* nA = has_next ? (const char*)g.A + (size_t)nxt.pm * tstepA + (size_t)nxt.ko * 2 : cA; const char* nB = has_next ? (const char*)g.Bt + (size_t)nxt.pn * tstepB + (size_t)nxt.ko * 2 : cB;
        for (int t = 0; t < nt; t += 2) {
            const bool last = (t == nt - 2);
            const char* a1 = cA + (size_t)(t + 1) * kstep;
            const char* a2 = last ? nA : cA + (size_t)(t + 2) * kstep; const char* b2 = last ? nB : cB + (size_t)(t + 2) * kstep;
            const char* a3 = a2 + kstep; const char* b3 = b2 + kstep;
            if (last && has_next) S.a_ready(nxt);
            if constexpr (SP2) {
            PG8_LDB(B0, 0, 0); PG8_LDB(B1, 0, 1); PG8_SCHED; PG8_LDA(At, 0, 0); PG8_STAGE(PG8_SA(1, 1), a1 + hstepA, voffA);
            PG8_WAIT_V(8); PG8_WAIT_L(0); PG8_BAR; PG8_MMA(0, 0, At, B0); PG8_MMA(0, 1, At, B1); PG8_BAR; PG8_SCHED;
            PG8_LDA(At, 0, 1); PG8_STAGE(PG8_SB(0, 0), b2, voffB); PG8_STAGE(PG8_SB(0, 1), b2 + hstepB, voffB); PG8_STAGE(PG8_SA(0, 0), a2, voffA);
            PG8_WAIT_V(8); PG8_WAIT_L(0); PG8_BAR; PG8_MMA(1, 0, At, B0); PG8_MMA(1, 1, At, B1); PG8_BAR; PG8_SCHED;
            PG8_LDB(B0, 1, 0); PG8_LDB(B1, 1, 1); PG8_SCHED; PG8_LDA(At, 1, 0); PG8_STAGE(PG8_SA(0, 1), a2 + hstepA, voffA);
            PG8_WAIT_V(8); PG8_WAIT_L(0); PG8_BAR; PG8_MMA(0, 0, At, B0); PG8_MMA(0, 1, At, B1); PG8_BAR; PG8_SCHED;
            PG8_LDA(At, 1, 1); PG8_STAGE(PG8_SB(1, 0), b3, voffB); PG8_STAGE(PG8_SB(1, 1), b3 + hstepB, voffB); PG8_STAGE(PG8_SA(1, 0), a3, voffA);
            PG8_WAIT_V(8); PG8_WAIT_L(0); PG8_BAR; PG8_MMA(1, 0, At, B0); PG8_MMA(1, 1, At, B1); PG8_BAR; PG8_SCHED;
            } else {
            PG8_LDB(B0, 0, 0); PG8_SCHED; PG8_LDA(At, 0, 0); PG8_STAGE(PG8_SA(1, 1), a1 + hstepA, voffA);
            PG8_WAIT_L(8); PG8_BAR; PG8_WAIT_L(0); PG8_MMA(0, 0, At, B0); PG8_BAR; PG8_SCHED;
            PG8_LDB(B1, 0, 1); PG8_STAGE(PG8_SB(0, 0), b2, voffB);
            PG8_BAR; PG8_WAIT_L(0); PG8_MMA(0, 1, At, B1); PG8_BAR;
            PG8_LDA(At, 0, 1); PG8_STAGE(PG8_SA(0, 0), a2, voffA);
            PG8_BAR; PG8_WAIT_L(0); PG8_MMA(1, 0, At, B0); PG8_BAR; PG8_SCHED;
            PG8_STAGE(PG8_SB(0, 1), b2 + hstepB, voffB);
            PG8_WAIT_V(6); PG8_BAR; PG8_MMA(1, 1, At, B1); PG8_BAR;
            PG8_LDB(B0, 1, 0); PG8_SCHED; PG8_LDA(At, 1, 0); PG8_STAGE(PG8_SA(0, 1), a2 + hstepA, voffA);
            PG8_WAIT_L(8); PG8_BAR; PG8_WAIT_L(0); PG8_MMA(0, 0, At, B0); PG8_BAR; PG8_SCHED;
            PG8_LDB(B1, 1, 1); PG8_STAGE(PG8_SB(1, 0), b3, voffB);
            PG8_BAR; PG8_WAIT_L(0); PG8_MMA(0, 1, At, B1); PG8_BAR;
            PG8_LDA(At, 1, 1); PG8_STAGE(PG8_SA(1, 0), a3, voffA);
            PG8_BAR; PG8_WAIT_L(0); PG8_MMA(1, 0, At, B0); PG8_BAR; PG8_SCHED;
            PG8_STAGE(PG8_SB(1, 1), b3 + hstepB, voffB);
            PG8_WAIT_V(6); PG8_BAR; PG8_MMA(1, 1, At, B1); PG8_BAR;
            }
        }
        if constexpr (ALIGN_EPI) { if (wr == 0) PG8_BAR; }
        if constexpr (!Epi::AFTER_DRAIN) { E(acc, cur, wr, wc, fr, fq); S.done(cur); }
        if (!has_next) break;
#pragma unroll
        for (int a = 0; a < 2; ++a)
#pragma unroll
            for (int b = 0; b < 2; ++b)
#pragma unroll
                for (int m = 0; m < 4; ++m)
#pragma unroll
                    for (int n = 0; n < 2; ++n) acc[a][b][m][n] = (f32x4){0.f, 0.f, 0.f, 0.f};
        cur = nxt; cA = nA; cB = nB; ++ui;
        if constexpr (ALIGN_EPI) { if (wr == 1) PG8_BAR; }
    }
    PG8_WAIT_V(0);
    if constexpr (!ALIGN_EPI) { if (wr == 0) PG8_BAR; }
    PG8_BAR;
    if constexpr (Epi::AFTER_DRAIN) { E.fused(acc, cur, wr, wc, fr, fq, lds, wid, lane); S.done(cur); }
#undef PG8_SA
#undef PG8_SB
#undef PG8_STAGE
#undef PG8_LDA
#undef PG8_LDB
#undef PG8_MMA
#undef PG8_WAIT_V
#undef PG8_WAIT_L
#undef PG8_BAR
#undef PG8_SCHED
}
}


DEV float fast_silu(float g) { return g * __builtin_amdgcn_rcpf(1.f + __expf(-g)); }
DEV float fast_gelu(float x) { const float u = 0.7978845608028654f * (x + 0.044715f * x * x * x); const float e = __expf(2.f * u); return x * (1.f - __builtin_amdgcn_rcpf(e + 1.f)); }
typedef pg8::f32x4 pf4;
struct EpiSwiGLU { static constexpr bool PERM = true, AFTER_DRAIN = false; u16* HID;
    DEV void operator()(const pf4 (&acc)[2][2][4][2], const pg8::Unit& u, int wr, int wc, int fr_, int fq_) const {
        int fr = fr_, fq = fq_; asm volatile("" : "+v"(fr), "+v"(fq));
        const int row0 = u.pm * 256 + wr * 64 + fr, col0 = u.pn * 128 + wc * 32 + 8 * fq;
#pragma unroll
        for (int ai = 0; ai < 2; ++ai)
#pragma unroll
            for (int m = 0; m < 4; ++m) {
                const pf4 g0 = acc[ai][0][m][0], g1 = acc[ai][0][m][1], u0 = acc[ai][1][m][0], u1 = acc[ai][1][m][1];
                u32x4 w; w.x = pk2(fast_silu(g0[0]) * u0[0], fast_silu(g0[1]) * u0[1]); w.y = pk2(fast_silu(g0[2]) * u0[2], fast_silu(g0[3]) * u0[3]);
                w.z = pk2(fast_silu(g1[0]) * u1[0], fast_silu(g1[1]) * u1[1]); w.w = pk2(fast_silu(g1[2]) * u1[2], fast_silu(g1[3]) * u1[3]);
                *(u32x4*)(HID + (size_t)(row0 + ai * 128 + m * 16) * FH + col0) = w;
            }
    } };
struct EpiResid { static constexpr bool PERM = false, AFTER_DRAIN = false; const float* bctx; const float* blat; float* H; const float* mvl; const float* mvc; float mul;
    DEV void operator()(const pf4 (&acc)[2][2][4][2], const pg8::Unit& u, int wr, int wc, int fr_, int fq_) const {
        int fr = fr_, fq = fq_; asm volatile("" : "+v"(fr), "+v"(fq));
        const int row0 = u.pm * 256 + wr * 64 + fr, col0 = u.pn * 256 + wc * 32 + 4 * fq;
        const float* mv = u.pm == 0 ? mvc : mvl;
        pf4 mm[2][2];
#pragma unroll
        for (int bj = 0; bj < 2; ++bj)
#pragma unroll
            for (int n = 0; n < 2; ++n) mm[bj][n] = *(const pf4*)(mv + col0 + bj * 128 + n * 16) * mul;
#pragma unroll
        for (int ai = 0; ai < 2; ++ai)
#pragma unroll
            for (int m = 0; m < 4; ++m) {
                const int r = row0 + ai * 128 + m * 16;
                const float* bp = (r < NCTX ? bctx + (size_t)r * D : blat + (size_t)(r - NCTX) * D) + col0; float* hp = H + (size_t)r * D + col0;
#pragma unroll
                for (int bj = 0; bj < 2; ++bj)
#pragma unroll
                    for (int n = 0; n < 2; ++n) { const pf4 b = *(const pf4*)(bp + bj * 128 + n * 16); *(pf4*)(hp + bj * 128 + n * 16) = b + mm[bj][n] * acc[ai][bj][m][n]; }
            }
    } };
template <int mode, int SITE, int MVOFF, int SHOFF, int NGOFF, bool FROM_IN, int MUL2> struct EpiResidNorm { static constexpr bool PERM = false, AFTER_DRAIN = true;
    unsigned char* wsb; const float* ngbase; const float* xin; float* out;
    DEV void fused(pf4 (&acc)[2][2][4][2], const pg8::Unit& u, int wr, int wc, int fr_, int fq_, PG8_LAS unsigned char* lds, int wid, int lane) const {
        int fr = fr_, fq = fq_; asm volatile("" : "+v"(fr), "+v"(fq));
        PG8_LAS float* P = (PG8_LAS float*)lds; PG8_LAS float* S = (PG8_LAS float*)(lds + 8192);
        float* H = (float*)(wsb + WS_H); const float* blat = FROM_IN ? xin : H + (size_t)NCTX * D; const float* mvl = (const float*)(wsb + WS_MV) + MVOFF; const float* shv = (const float*)(wsb + WS_MV) + SHOFF;
        const float* ng = ngbase + NGOFF; u16* XN = (u16*)(wsb + WS_XN); unsigned long long* rss = (unsigned long long*)(wsb + WS_RSS) + (size_t)SITE * R; unsigned* cnt = (unsigned*)(wsb + WS_BAR + 16 * KiB) + SITE * 65 * 16; const float mul = 0.5f * MUL2;
        const int rl0 = wr * 64 + fr, col0 = u.pn * 256 + wc * 32 + 4 * fq;
        {
            pf4 mm[2][2];
#pragma unroll
            for (int bj = 0; bj < 2; ++bj)
#pragma unroll
                for (int n = 0; n < 2; ++n) mm[bj][n] = *(const pf4*)(mvl + col0 + bj * 128 + n * 16) * mul;
#pragma unroll
            for (int ai = 0; ai < 2; ++ai)
#pragma unroll
                for (int m = 0; m < 4; ++m) {
                    const int rl = rl0 + ai * 128 + m * 16; const size_t r = (size_t)u.pm * 256 + rl;
                    const float* bp = blat + (r - NCTX) * D + col0; float* hp = H + r * D + col0; float ss = 0.f;
#pragma unroll
                    for (int bj = 0; bj < 2; ++bj)
#pragma unroll
                        for (int n = 0; n < 2; ++n) { const pf4 hv = *(const pf4*)(bp + bj * 128 + n * 16) + mm[bj][n] * acc[ai][bj][m][n]; acc[ai][bj][m][n] = hv;
                            ss += (hv[0] * hv[0] + hv[1] * hv[1]) + (hv[2] * hv[2] + hv[3] * hv[3]); if (mode == 0) *(pf4*)(hp + bj * 128 + n * 16) = hv; }
                    ss += __shfl_xor(ss, 16); ss += __shfl_xor(ss, 32);
                    if (fq == 0) P[rl * 4 + wc] = ss;
                    asm volatile("" ::: "memory");
                }
        }
        asm volatile("s_waitcnt lgkmcnt(0)" ::: "memory"); __builtin_amdgcn_s_barrier(); asm volatile("" ::: "memory");
        const int row = wid * 32 + (lane & 31);
        if (lane < 32) { const float t = (P[row * 4 + 0] + P[row * 4 + 1]) + (P[row * 4 + 2] + P[row * 4 + 3]);
            __hip_atomic_fetch_add(rss + (size_t)u.pm * 256 + row, (unsigned long long)(t * 16777216.f), __ATOMIC_RELAXED, __HIP_MEMORY_SCOPE_AGENT); }
        asm volatile("s_waitcnt vmcnt(0)" ::: "memory");
        if (lane == 0) __hip_atomic_fetch_add(cnt + 16 * u.pm, 1u, __ATOMIC_RELAXED, __HIP_MEMORY_SCOPE_AGENT);
        if (wid == 0) {
            unsigned sp = 0;
            while ((unsigned)__builtin_amdgcn_readfirstlane(__hip_atomic_load(cnt + 16 * u.pm, __ATOMIC_RELAXED, __HIP_MEMORY_SCOPE_AGENT)) < 32u) { __builtin_amdgcn_s_sleep(2); if (++sp > (1u << 22)) break; }
            __builtin_amdgcn_fence(__ATOMIC_ACQUIRE, "agent");
        }
        asm volatile("s_waitcnt vmcnt(0) lgkmcnt(0)" ::: "memory"); __builtin_amdgcn_s_barrier(); asm volatile("" ::: "memory");
        if (lane < 32) { const unsigned long long a = __hip_atomic_fetch_add(rss + (size_t)u.pm * 256 + row, 0ull, __ATOMIC_RELAXED, __HIP_MEMORY_SCOPE_AGENT);
            const float t = (float)a * (1.f / 16777216.f);
            S[row] = rsqrtf(t * (1.f / D) + EPS); }
        asm volatile("s_waitcnt lgkmcnt(0)" ::: "memory"); __builtin_amdgcn_s_barrier(); asm volatile("" ::: "memory");
#pragma unroll
        for (int bj = 0; bj < 2; ++bj)
#pragma unroll
            for (int n = 0; n < 2; ++n) {
                const int c = col0 + bj * 128 + n * 16;
                pf4 gm = *(const pf4*)(ng + c), sh = (pf4){0.f, 0.f, 0.f, 0.f};
                if (mode == 0) { gm = gm * (*(const pf4*)(shv + D + c) + 1.f); sh = *(const pf4*)(shv + c); }
#pragma unroll
                for (int ai = 0; ai < 2; ++ai)
#pragma unroll
                    for (int m = 0; m < 4; ++m) {
                        const int rl = rl0 + ai * 128 + m * 16; const size_t r = (size_t)u.pm * 256 + rl; const float rs = S[rl];
                        const pf4 y = acc[ai][bj][m][n] * rs * gm + sh;
                        if (mode == 0) { u32x2 w; w.x = pk2(y[0], y[1]); w.y = pk2(y[2], y[3]); *(u32x2*)(XN + r * D + c) = w; }
                        else *(pf4*)(out + (r - NCTX) * D + c) = y;
                    }
                asm volatile("" ::: "memory");
            }
        asm volatile("s_waitcnt lgkmcnt(0)" ::: "memory"); __builtin_amdgcn_s_barrier(); asm volatile("" ::: "memory");
    } };
struct EpiPartial { static constexpr bool PERM = false, AFTER_DRAIN = false; float* P; const float* mv; float mul; int kc;
    DEV void operator()(const pf4 (&acc)[2][2][4][2], const pg8::Unit& u, int wr, int wc, int fr_, int fq_) const {
        int fr = fr_, fq = fq_; asm volatile("" : "+v"(fr), "+v"(fq));
        const int row0 = (u.ko / kc) * 256 + wr * 64 + fr, col0 = u.pn * 256 + wc * 32 + 4 * fq;
#pragma unroll
        for (int ai = 0; ai < 2; ++ai)
#pragma unroll
            for (int m = 0; m < 4; ++m) {
                float* pp = P + (size_t)(row0 + ai * 128 + m * 16) * D + col0;
#pragma unroll
                for (int bj = 0; bj < 2; ++bj)
#pragma unroll
                    for (int n = 0; n < 2; ++n) *(pf4*)(pp + bj * 128 + n * 16) = *(const pf4*)(mv + col0 + bj * 128 + n * 16) * mul * acc[ai][bj][m][n];
                asm volatile("" ::: "memory");
            }
    } };
struct EpiML { static constexpr bool PERM = true, AFTER_DRAIN = false; u16* PM; float* G; const float* gb;
    DEV void operator()(const pf4 (&acc)[2][2][4][2], const pg8::Unit& u, int wr, int wc, int fr_, int fq_) const {
        int fr = fr_, fq = fq_; asm volatile("" : "+v"(fr), "+v"(fq));
        const int row0 = u.pm * 256 + wr * 64 + fr;
        if (u.pn < 12) {
            const int col0 = u.pn * 256 + wc * 32 + 8 * fq;
#pragma unroll
            for (int ai = 0; ai < 2; ++ai)
#pragma unroll
                for (int m = 0; m < 4; ++m)
#pragma unroll
                    for (int bj = 0; bj < 2; ++bj) { const pf4 a = acc[ai][bj][m][0], b = acc[ai][bj][m][1];
                        u32x4 w; w.x = pk2(a[0], a[1]); w.y = pk2(a[2], a[3]); w.z = pk2(b[0], b[1]); w.w = pk2(b[2], b[3]);
                        *(u32x4*)(PM + (size_t)(row0 + ai * 128 + m * 16) * PMW + col0 + bj * 128) = w; }
        } else if (wc == 0) {
            const pf4 b0 = *(const pf4*)(gb + 8 * fq), b1 = *(const pf4*)(gb + 8 * fq + 4);
#pragma unroll
            for (int ai = 0; ai < 2; ++ai)
#pragma unroll
                for (int m = 0; m < 4; ++m) { float* gp = G + (size_t)(row0 + ai * 128 + m * 16) * 32 + 8 * fq; *(pf4*)gp = acc[ai][0][m][0] + b0; *(pf4*)(gp + 4) = acc[ai][0][m][1] + b1; }
        }
    } };
struct EpiAB { static constexpr bool PERM = false, AFTER_DRAIN = false; u16* P0; const float* gng; const float* qg; const float* kg; const float* rt;
    static DEV void store16(u16* dp, const pf4 (&v)[2][2]) {
#pragma unroll
        for (int bj = 0; bj < 2; ++bj)
#pragma unroll
            for (int n = 0; n < 2; ++n) { u32x2 w; w.x = pk2(v[bj][n][0], v[bj][n][1]); w.y = pk2(v[bj][n][2], v[bj][n][3]); *(u32x2*)(dp + 32 * bj + 16 * n) = w; }
    }
    DEV void operator()(const pf4 (&acc)[2][2][4][2], const pg8::Unit& u, int wr, int wc, int fr_, int fq_) const {
        int fr = fr_, fq = fq_; asm volatile("" : "+v"(fr), "+v"(fq));
        const int row0 = u.pm * 256 + wr * 64 + fr, colw = u.pn * 256 + wc * 64 + 4 * fq;
        const int kind = u.pn < 2 ? 0 : (u.pn < 4 ? 1 : (u.pn < 6 ? 2 : (wc < 2 ? 3 : 4)));
        if (kind == 0 || kind == 4) {
#pragma unroll
            for (int ai = 0; ai < 2; ++ai)
#pragma unroll
                for (int m = 0; m < 4; ++m) {
                    pf4 v[2][2];
#pragma unroll
                    for (int bj = 0; bj < 2; ++bj)
#pragma unroll
                        for (int n = 0; n < 2; ++n)
#pragma unroll
                            for (int j = 0; j < 4; ++j) v[bj][n][j] = kind == 0 ? fast_gelu(acc[ai][bj][m][n][j]) : acc[ai][bj][m][n][j];
                    store16(P0 + (size_t)(row0 + ai * 128 + m * 16) * EVEN_IN + colw, v);
                    asm volatile("" ::: "memory");
                }
            return;
        }
        const float* gp = kind == 1 ? gng + (colw - 512) : (kind == 2 ? qg : kg) + 4 * fq;
        const bool rope = kind >= 2 && u.pm > 0;
        const float osc = kind == 2 ? C2 : 1.f;
#pragma unroll
        for (int ai = 0; ai < 2; ++ai)
#pragma unroll
            for (int m = 0; m < 4; ++m) {
                const int r = row0 + ai * 128 + m * 16;
                pf4 v[2][2]; float ss = 0.f;
#pragma unroll
                for (int bj = 0; bj < 2; ++bj)
#pragma unroll
                    for (int n = 0; n < 2; ++n)
#pragma unroll
                        for (int j = 0; j < 4; ++j) { const float a = acc[ai][bj][m][n][j]; const float x = kind == 1 ? fast_gelu(a) : a; v[bj][n][j] = x; ss += x * x; }
                ss += __shfl_xor(ss, 16); ss += __shfl_xor(ss, 32);
                const float rs = rsqrtf(ss * (1.f / 64) + EPS) * osc;
#pragma unroll
                for (int bj = 0; bj < 2; ++bj)
#pragma unroll
                    for (int n = 0; n < 2; ++n) v[bj][n] = v[bj][n] * rs * *(const pf4*)(gp + 32 * bj + 16 * n);
                if (rope) {
                    const int t = r - NCTX;
#pragma unroll
                    for (int bj = 0; bj < 2; ++bj) {
                        const float* tp = rt + (bj == 0 ? (t >> 6) : (t & 63)) * 32 + 4 * fq;
                        const pf4 cs = *(const pf4*)tp, sn = *(const pf4*)(tp + 16);
                        const pf4 x1 = v[bj][0], x2 = v[bj][1]; v[bj][0] = x1 * cs - x2 * sn; v[bj][1] = x2 * cs + x1 * sn;
                    }
                }
                store16(P0 + (size_t)r * EVEN_IN + colw, v);
                asm volatile("" ::: "memory");
            }
    } };

#include <hip/hip_bf16.h>
namespace attn_body {
using bf16=__hip_bfloat16;
using bf16x8=__attribute__((ext_vector_type(8)))short;
using s16x4=__attribute__((ext_vector_type(4)))short;
using f32x16=__attribute__((ext_vector_type(16)))float;
using u32x4=__attribute__((ext_vector_type(4)))unsigned;
constexpr int D=64,PQ=1792,PO=1024;
constexpr int NW=8,QBLK=32,QB=QBLK*NW,KVBLK=64;
__device__ __forceinline__ int crow(int r,int hi){return (r&3)+8*(r>>2)+4*hi;}
#define SBAR() __builtin_amdgcn_sched_barrier(0)
__device__ __forceinline__ void cmask(f32x16&p0,f32x16&p1,int jb,int qrel,int hi){
  const float NEG=-INFINITY; int kb=64*jb+4*hi;
  #pragma unroll
  for(int r=0;r<16;++r){int kv=kb+(r&3)+8*(r>>2); if(kv>qrel)p0[r]=NEG; if(kv+32>qrel)p1[r]=NEG;}
}

constexpr int NSLOT=3, SLOTB=8192;
constexpr int LDS_K=0, LDS_V=NSLOT*SLOTB, LDS_WS=2*NSLOT*SLOTB, LDS_OST=LDS_WS+NW*64*4, LDS_BYTES=LDS_OST+NW*4096;
constexpr float C2=0.125f*1.4426950408889634f;
__device__ __forceinline__ void glds16(const void*gsrc,unsigned lds_dst){unsigned keep;
  asm volatile("s_mov_b32 %0, m0\n\ts_mov_b32 m0, %2\n\ts_nop 0\n\tglobal_load_lds_dwordx4 %1, off\n\ts_mov_b32 m0, %0":"=&s"(keep):"v"(gsrc),"s"(lds_dst):"memory");}
__device__ __forceinline__ float max3f(float a,float b,float c){float r;asm("v_max3_f32 %0, %1, %2, %3":"=v"(r):"v"(a),"v"(b),"v"(c));return r;}
__device__ __forceinline__ float max2f(float a,float b){float r;asm("v_max_f32_e32 %0, %1, %2":"=v"(r):"v"(a),"v"(b));return r;}
__device__ __forceinline__ float fadd_s(float a,float b){float r;asm("v_add_f32_e32 %0, %1, %2":"=v"(r):"v"(a),"v"(b));return r;}
__device__ __forceinline__ float fsub_s(float a,float b){float r;asm("v_sub_f32_e32 %0, %1, %2":"=v"(r):"v"(a),"v"(b));return r;}
typedef float f32x2_t __attribute__((ext_vector_type(2))); typedef __bf16 bf16x2_t __attribute__((ext_vector_type(2)));
__device__ __forceinline__ unsigned cvtpk_s(float lo,float hi){f32x2_t v={lo,hi};bf16x2_t b=__builtin_convertvector(v,bf16x2_t);return __builtin_bit_cast(unsigned,b);}
#define WAIT_BAR(N) asm volatile("s_waitcnt vmcnt(" #N ") lgkmcnt(0)\n\ts_barrier":::"memory")

__device__ __forceinline__ void qkt(f32x16&p0,f32x16&p1,const char*Kslot,const bf16x8*qr,const f32x16&negm,int r32,int hi){
  const char*kb=Kslot+hi*1024+r32*16;
  #pragma unroll
  for(int d0=0;d0<4;++d0){
    const bf16x8 b0=*reinterpret_cast<const bf16x8*>(kb+d0*2048);
    const bf16x8 b1=*reinterpret_cast<const bf16x8*>(kb+d0*2048+512);
    if(d0==0){p0=__builtin_amdgcn_mfma_f32_32x32x16_bf16(b0,qr[0],negm,0,0,0);p1=__builtin_amdgcn_mfma_f32_32x32x16_bf16(b1,qr[0],negm,0,0,0);}
    else{p0=__builtin_amdgcn_mfma_f32_32x32x16_bf16(b0,qr[d0],p0,0,0,0);p1=__builtin_amdgcn_mfma_f32_32x32x16_bf16(b1,qr[d0],p1,0,0,0);}}
}
typedef __attribute__((address_space(3))) const char* lds_cptr;
typedef short v4i16_t __attribute__((ext_vector_type(4)));
__device__ __forceinline__ void kload8(bf16x8*kf,lds_cptr kp){
  kf[0]=*(const __attribute__((address_space(3))) bf16x8*)(kp);      kf[1]=*(const __attribute__((address_space(3))) bf16x8*)(kp+512);
  kf[2]=*(const __attribute__((address_space(3))) bf16x8*)(kp+2048); kf[3]=*(const __attribute__((address_space(3))) bf16x8*)(kp+2560);
  kf[4]=*(const __attribute__((address_space(3))) bf16x8*)(kp+4096); kf[5]=*(const __attribute__((address_space(3))) bf16x8*)(kp+4608);
  kf[6]=*(const __attribute__((address_space(3))) bf16x8*)(kp+6144); kf[7]=*(const __attribute__((address_space(3))) bf16x8*)(kp+6656);
}
__device__ __forceinline__ void kload2(bf16x8*kf,lds_cptr kp,int j){ kf[2*j]=*(const __attribute__((address_space(3))) bf16x8*)(kp+j*2048); kf[2*j+1]=*(const __attribute__((address_space(3))) bf16x8*)(kp+j*2048+512); }
__device__ __forceinline__ s16x4 vtr(lds_cptr p){ return __builtin_bit_cast(s16x4,__builtin_amdgcn_ds_read_tr16_b64_v4i16((__attribute__((address_space(3))) v4i16_t*)p)); }
__device__ __forceinline__ float rowmax(const f32x16&p0,const f32x16&p1){
  float a=max3f(p0[0],p0[1],p1[0]),b=max3f(p0[2],p0[3],p1[1]);a=max3f(a,p1[2],p1[3]);
  #pragma unroll
  for(int r=4;r<16;r+=4){a=max3f(a,p0[r],p0[r+1]);b=max3f(b,p0[r+2],p0[r+3]);a=max3f(a,p1[r],p1[r+1]);b=max3f(b,p1[r+2],p1[r+3]);}
  const float m=max2f(a,b);
  auto rr=__builtin_amdgcn_permlane32_swap(__float_as_uint(m),__float_as_uint(m),false,false);
  return max2f(__uint_as_float(rr[0]),__uint_as_float(rr[1]));
}
__device__ __forceinline__ void pv(f32x16*o,int vb,bf16x8 pa0,bf16x8 pa1,bf16x8 pa2,bf16x8 pa3){
  #pragma unroll
  for(int d0=0;d0<2;++d0){s16x4 lo[4],hi[4];
    #pragma unroll
    for(int ks=0;ks<4;++ks){
      asm volatile("ds_read_b64_tr_b16 %0,%1 offset:%c2":"=&v"(lo[ks]):"v"(vb),"i"(d0*4096+ks*1024):"memory");
      asm volatile("ds_read_b64_tr_b16 %0,%1 offset:%c2":"=&v"(hi[ks]):"v"(vb),"i"(d0*4096+ks*1024+512):"memory");}
    asm volatile("s_waitcnt lgkmcnt(0)":::"memory");SBAR();
    #define PK(k) (bf16x8){lo[k][0],lo[k][1],lo[k][2],lo[k][3],hi[k][0],hi[k][1],hi[k][2],hi[k][3]}
    o[d0]=__builtin_amdgcn_mfma_f32_32x32x16_bf16(pa0,PK(0),o[d0],0,0,0);
    o[d0]=__builtin_amdgcn_mfma_f32_32x32x16_bf16(pa1,PK(1),o[d0],0,0,0);
    o[d0]=__builtin_amdgcn_mfma_f32_32x32x16_bf16(pa2,PK(2),o[d0],0,0,0);
    o[d0]=__builtin_amdgcn_mfma_f32_32x32x16_bf16(pa3,PK(3),o[d0],0,0,0);
    #undef PK
  }
}

#ifndef ATTN_STORE16
#define ATTN_STORE16(p,v) (*(u32x4*)(p)=(v))
#endif
template<int THRL> __device__ __forceinline__ void attn_unit(float sref,int q0,int NT,const bf16*Q,const bf16*__restrict__ Kh,const bf16*__restrict__ Vh,bf16*O,char*shm){
  const int tid=tid_fresh(),lane=tid&63,r32=lane&31,hi=lane>>5; const int wid=__builtin_amdgcn_readfirstlane(tid>>6);
  const bf16*Qw=Q+(long)(q0+wid*QBLK)*PQ;
  const unsigned lds0=(unsigned)(uintptr_t)shm;
  float*wsf=(float*)(shm+LDS_WS)+wid*64;
  const bf16*ksrc=Kh+(long)lane*PQ+wid*8;
  const bf16*vsrc=Vh+(long)(16*(wid&3)+(lane>>2))*PQ+(wid>>2)*32+(lane&3)*8;
  const unsigned kdst=lds0+LDS_K+wid*1024, vdst=lds0+LDS_V+wid*1024;
  #define DMA_K(t,slot) glds16(ksrc+(long)(t)*KVBLK*PQ,(unsigned)__builtin_amdgcn_readfirstlane(kdst+(slot)))
  #define DMA_V(t,slot) glds16(vsrc+(long)(t)*KVBLK*PQ,(unsigned)__builtin_amdgcn_readfirstlane(vdst+(slot)))
  const int vb0=(int)(lds0+LDS_V)+((lane>>4)&1)*32+(lane&3)*8+(4*hi+((lane&15)>>2))*64;
  const char*Kbase=shm+LDS_K; bf16x8 kf[8];
  const lds_cptr shm3=(lds_cptr)shm; const lds_cptr kp0=shm3+LDS_K+hi*1024+r32*16; const lds_cptr vp0=shm3+LDS_V+((lane>>4)&1)*32+(lane&3)*8+(4*hi+((lane&15)>>2))*64;
  DMA_K(0,0);DMA_V(0,0);DMA_K(1,SLOTB);
  bf16x8 qr[4];
  #pragma unroll
  for(int d0=0;d0<4;++d0)qr[d0]=*reinterpret_cast<const bf16x8*>(&Qw[(long)r32*PQ+d0*16+hi*8]);
  float mhat=0.f,l_reg=0.f;f32x16 o[2];o[0]=f32x16{};o[1]=f32x16{};f32x16 negm=f32x16{};asm volatile("":"+v"(negm));
  #define CMASK(P0,P1,t) do{}while(0)
  bool resc=false;
  #define START(P0,P1) do{ const float rm=FIXEDREF?sref:rowmax(P0,P1); resc=false; \
    { const float dl=rm; mhat=fadd_s(mhat,dl); \
      _Pragma("unroll") for(int r=0;r<16;++r){P0[r]=fsub_s(P0[r],dl);P1[r]=fsub_s(P1[r],dl);} \
      _Pragma("unroll") for(int r=0;r<16;++r)negm[r]=-mhat; asm volatile("":"+v"(negm)); } \
    _Pragma("unroll") for(int r=0;r<16;++r)P0[r]=__builtin_amdgcn_exp2f(P0[r]); }while(0)
  #define RESC() do{ if(resc){ asm volatile("s_waitcnt lgkmcnt(0)":::"memory"); \
      _Pragma("unroll") for(int d_=0;d_<2;++d_) _Pragma("unroll") for(int r=0;r<16;++r)o[d_][r]*=wsf[crow(r,hi)]; } }while(0)
  f32x16 pA0,pA1,pB0,pB1;
  int sl_prev=0,sl_cur=0,sl_next=SLOTB;
  #define ROT() do{sl_prev=sl_cur;sl_cur=sl_next;sl_next=(sl_next==(NSLOT-1)*SLOTB)?0:sl_next+SLOTB;}while(0)
  DMA_K(2,2*SLOTB);
  WAIT_BAR(3);
  qkt(pA0,pA1,Kbase,qr,negm,r32,hi);asm volatile("s_nop 15\n\ts_nop 7":"+v"(pA0),"+v"(pA1));CMASK(pA0,pA1,0);
  START(pA0,pA1);
  _Pragma("unroll") for(int r=0;r<16;++r)pA1[r]=__builtin_amdgcn_exp2f(pA1[r]);
  WAIT_BAR(0);
  DMA_K(3,0);DMA_V(1,SLOTB);
  ROT();
  kload8(kf,kp0+sl_cur);
  WAIT_BAR(2);
  s16x4 vlo[8],vhi[8]; u32x4 pw0,pw1,pw2,pw3;
  #define PKW(P,B) cvtpk_s(P[B],P[B+1])
  #define PAF(k) __builtin_bit_cast(bf16x8,pw##k)
  #define VFR(i) (bf16x8){vlo[i][0],vlo[i][1],vlo[i][2],vlo[i][3],vhi[i][0],vhi[i][1],vhi[i][2],vhi[i][3]}
  #define PIN(x) asm volatile("":"+v"(x))
  #define MX3(a,b,c) __builtin_fmaxf(__builtin_fmaxf((a),(b)),(c))
  #define GAPA(MF,A0,A1,A2,A3,W0,W1,PW) do{ MF; sacc+=A0; sacc+=A1; sacc+=A2; sacc+=A3; PIN(sacc); W0; W1; PIN(PW); SBAR(); }while(0)
  #define EX(v) __builtin_amdgcn_exp2f(v)
  #define GAPB(MF,X,B) do{ MF; X[B]=EX(X[B]); X[B+1]=EX(X[B+1]); X[B+2]=EX(X[B+2]); X[B+3]=EX(X[B+3]); PIN(X); SBAR(); }while(0)
  #define VRD(i) do{ vlo[i]=vtr(vp_+(((i)>>2)*4096+((i)&3)*1024)); vhi[i]=vtr(vp_+(((i)>>2)*4096+((i)&3)*1024+512)); }while(0)
  #define KRD(G,j) do{ if(G){ kload2(kf,kp0+sl_next,j); SBAR(); } }while(0)
  #define STEP(C0,C1,P0,P1,t,GK,GV,GL) do{ SBAR(); \
    const lds_cptr vp_=vp0+sl_prev; \
    VRD(0); SBAR(); float sacc=(P0[0]+P0[1]); \
    GAPA(C0=__builtin_amdgcn_mfma_f32_32x32x16_bf16(kf[0],qr[0],negm,0,0,0), P0[2],P0[3],P0[4],P0[5],     pw0[0]=PKW(P0,0), pw0[1]=PKW(P0,2), pw0); \
    VRD(4); SBAR(); GAPA(C1=__builtin_amdgcn_mfma_f32_32x32x16_bf16(kf[1],qr[0],negm,0,0,0), P0[6],P0[7],P0[8],P0[9],     pw0[2]=PKW(P0,4), pw0[3]=PKW(P0,6), pw0); \
    VRD(1); SBAR(); GAPA(C0=__builtin_amdgcn_mfma_f32_32x32x16_bf16(kf[2],qr[1],C0,0,0,0),   P0[10],P0[11],P0[12],P0[13], pw1[0]=PKW(P0,8), pw1[1]=PKW(P0,10), pw1); \
    VRD(5); SBAR(); GAPA(C1=__builtin_amdgcn_mfma_f32_32x32x16_bf16(kf[3],qr[1],C1,0,0,0),   P0[14],P0[15],P1[0],P1[1],   pw1[2]=PKW(P0,12),pw1[3]=PKW(P0,14), pw1); \
    VRD(2); SBAR(); GAPA(C0=__builtin_amdgcn_mfma_f32_32x32x16_bf16(kf[4],qr[2],C0,0,0,0),   P1[2],P1[3],P1[4],P1[5],     pw2[0]=PKW(P1,0), pw2[1]=PKW(P1,2), pw2); \
    VRD(6); SBAR(); GAPA(C1=__builtin_amdgcn_mfma_f32_32x32x16_bf16(kf[5],qr[2],C1,0,0,0),   P1[6],P1[7],P1[8],P1[9],     pw2[2]=PKW(P1,4), pw2[3]=PKW(P1,6), pw2); \
    VRD(3); SBAR(); GAPA(C0=__builtin_amdgcn_mfma_f32_32x32x16_bf16(kf[6],qr[3],C0,0,0,0),   P1[10],P1[11],P1[12],P1[13], pw3[0]=PKW(P1,8), pw3[1]=PKW(P1,10), pw3); \
    VRD(7); SBAR(); GAPA(C1=__builtin_amdgcn_mfma_f32_32x32x16_bf16(kf[7],qr[3],C1,0,0,0),   P1[14],P1[15],0.f,0.f,       pw3[2]=PKW(P1,12),pw3[3]=PKW(P1,14), pw3); \
    l_reg+=sacc; \
    if(GK){DMA_K((t)+3,sl_cur);} if(GV){DMA_V((t)+1,sl_next);} \
    CMASK(C0,C1,t); \
    { float a=MX3(C0[0],C0[1],C1[0]),b=MX3(C0[2],C0[3],C1[1]); a=MX3(a,C1[2],C1[3]); \
      _Pragma("unroll") for(int r=4;r<16;r+=4){a=MX3(a,C0[r],C0[r+1]);b=MX3(b,C0[r+2],C0[r+3]);a=MX3(a,C1[r],C1[r+1]);b=MX3(b,C1[r+2],C1[r+3]);} \
      float rm=__builtin_fmaxf(a,b); { auto rr=__builtin_amdgcn_permlane32_swap(__float_as_uint(rm),__float_as_uint(rm),false,false); rm=__builtin_fmaxf(__uint_as_float(rr[0]),__uint_as_float(rr[1])); } \
      resc=false; \
      if(!FIXEDREF&&__builtin_expect(__any(rm>(float)THRL),0)){ const float dl=__builtin_fmaxf(rm,0.f); mhat+=dl; \
        _Pragma("unroll") for(int r=0;r<16;++r){C0[r]-=dl;C1[r]-=dl;} \
        _Pragma("unroll") for(int r=0;r<16;++r)negm[r]=-mhat; asm volatile("":"+v"(negm)); \
        const float f=__builtin_amdgcn_exp2f(-dl); l_reg*=f; if(hi==0)wsf[r32]=f; resc=true; } } \
    SBAR(); \
    GAPB(o[0]=__builtin_amdgcn_mfma_f32_32x32x16_bf16(PAF(0),VFR(0),o[0],0,0,0), C0,0); \
    GAPB(o[1]=__builtin_amdgcn_mfma_f32_32x32x16_bf16(PAF(0),VFR(4),o[1],0,0,0), C0,4); \
    KRD(GL,0); GAPB(o[0]=__builtin_amdgcn_mfma_f32_32x32x16_bf16(PAF(1),VFR(1),o[0],0,0,0), C0,8); \
    KRD(GL,1); GAPB(o[1]=__builtin_amdgcn_mfma_f32_32x32x16_bf16(PAF(1),VFR(5),o[1],0,0,0), C0,12); \
    KRD(GL,2); GAPB(o[0]=__builtin_amdgcn_mfma_f32_32x32x16_bf16(PAF(2),VFR(2),o[0],0,0,0), C1,0); \
    KRD(GL,3); GAPB(o[1]=__builtin_amdgcn_mfma_f32_32x32x16_bf16(PAF(2),VFR(6),o[1],0,0,0), C1,4); \
    GAPB(o[0]=__builtin_amdgcn_mfma_f32_32x32x16_bf16(PAF(3),VFR(3),o[0],0,0,0), C1,8); \
    GAPB(o[1]=__builtin_amdgcn_mfma_f32_32x32x16_bf16(PAF(3),VFR(7),o[1],0,0,0), C1,12); \
    }while(0)
  int t=1;
  #undef CMASK
  #define CMASK(P0,P1,t) do{}while(0)
  for(;t+5<NT;t+=2){
    STEP(pB0,pB1,pA0,pA1,t,true,true,true);     WAIT_BAR(2); RESC(); ROT();
    STEP(pA0,pA1,pB0,pB1,t+1,true,true,true);   WAIT_BAR(2); RESC(); ROT();
  }
  #undef CMASK
  #define CMASK(P0,P1,t) do{}while(0)
  #define ENDW(tt) do{ if((tt)+3<NT){WAIT_BAR(2);} else if((tt)+2<NT){WAIT_BAR(1);} else {WAIT_BAR(0);} }while(0)
  for(;t+1<NT;t+=2){
    STEP(pB0,pB1,pA0,pA1,t,(t+3<NT),(t+1<NT),(t+1<NT));       ENDW(t);   RESC(); ROT();
    STEP(pA0,pA1,pB0,pB1,t+1,(t+4<NT),(t+2<NT),(t+2<NT));     ENDW(t+1); RESC(); ROT();
  }
  STEP(pB0,pB1,pA0,pA1,NT-1,false,false,false); RESC();
  { float sacc=pB0[0]+pB0[1]; _Pragma("unroll") for(int r=2;r<16;++r)sacc+=pB0[r]; _Pragma("unroll") for(int r=0;r<16;++r)sacc+=pB1[r]; l_reg+=sacc;
    pw0=(u32x4){PKW(pB0,0),PKW(pB0,2),PKW(pB0,4),PKW(pB0,6)};pw1=(u32x4){PKW(pB0,8),PKW(pB0,10),PKW(pB0,12),PKW(pB0,14)};pw2=(u32x4){PKW(pB1,0),PKW(pB1,2),PKW(pB1,4),PKW(pB1,6)};pw3=(u32x4){PKW(pB1,8),PKW(pB1,10),PKW(pB1,12),PKW(pB1,14)};
    SBAR(); pv(o,vb0+sl_cur,PAF(0),PAF(1),PAF(2),PAF(3)); }
  #undef PKW
  #undef PAF
  #undef VFR
  #undef PIN
  #undef MX3
  #undef GAPA
  #undef GAPB
  #undef EX
  #undef VRD
  #undef KRD
  #undef STEP
  #undef ENDW
  {auto rr=__builtin_amdgcn_permlane32_swap(__float_as_uint(l_reg),__float_as_uint(l_reg),false,false);l_reg=__uint_as_float(rr[0])+__uint_as_float(rr[1]);}
  if(hi==0)wsf[32+r32]=l_reg;asm volatile("s_waitcnt lgkmcnt(0)":::"memory");
  float rli[16];
  #pragma unroll
  for(int r=0;r<16;++r)rli[r]=__builtin_amdgcn_rcpf(wsf[32+crow(r,hi)]);
  bf16*Ow=O+(long)(q0+wid*QBLK)*PO;
  { bf16*stg=(bf16*)(shm+LDS_OST)+wid*2048;
    #pragma unroll
    for(int r=0;r<16;++r){const int orow=crow(r,hi);
      #pragma unroll
      for(int d0=0;d0<2;++d0)stg[orow*64+d0*32+r32]=__float2bfloat16(o[d0][r]*rli[r]);}
    asm volatile("s_waitcnt lgkmcnt(0)":::"memory");
    #pragma unroll
    for(int i=0;i<4;++i){const int row=i*8+(lane>>3),ch=lane&7; const u32x4 v=*(const u32x4*)(stg+row*64+ch*8); ATTN_STORE16(Ow+(long)row*PO+ch*8,v);} }
  asm volatile("s_waitcnt lgkmcnt(0)\n\ts_barrier":::"memory");
  #undef DMA_K
  #undef DMA_V
  #undef CMASK
  #undef START
  #undef RESC
  #undef ROT
}
constexpr int ATTN_LDS_BYTES=LDS_BYTES;
#undef SBAR
#undef WAIT_BAR
}

DEV void phase_attn_fast(const Ctx& X, char* shm) {
    typedef attn_body::bf16 abf;
    const abf* P0 = (const abf*)X.BIG; abf* CAT = (abf*)X.XN;
    const int G = gridDim.x, bx = blockIdx.x, x8 = (G % 8 == 0), vcu = x8 ? (bx % 8) * (G / 8) + bx / 8 : bx;
    const int per = (512 + G - 1) / G;
    float mq = 0.f, mk = 0.f;
    for (int d = 0; d < 64; ++d) { mq = fmaxf(mq, fabsf(X.ab_q_norm_g[d])); mk = fmaxf(mk, fabsf(X.ab_k_norm_g[d])); }
    const float sref = 1.02f * C2 * 64.f * mq * mk;
    for (int i = 0; i < per; ++i) {
        const int u = vcu * per + i; if (u >= 512) break;
        const int h = u >> 6, qb = u & 63;
        attn_body::attn_unit<8>(sref, NCTX + qb * 256, R / 64, P0 + 1024 + h * 64, P0 + 1536 + (h >> 2) * 64, P0 + 1664 + (h >> 2) * 64, CAT + 512 + h * 64, shm);
    }
    for (int h = 0; h < 8; ++h) if (vcu == (x8 ? h * (G / 8) : h))
        attn_body::attn_unit<8>(sref, 0, NCTX / 64, P0 + 1024 + h * 64, P0 + 1536 + (h >> 2) * 64, P0 + 1664 + (h >> 2) * 64, CAT + 512 + h * 64, shm);
}


#define LAS __attribute__((address_space(3)))
typedef short v4i16_t __attribute__((ext_vector_type(4)));
typedef LAS unsigned char* lptr;
DEV bf16x8 mk8(v4i16_t a, v4i16_t b) { return __builtin_shufflevector(a, b, 0, 1, 2, 3, 4, 5, 6, 7); }
DEV bf16x8 tr_frag(lptr tile, int stride, int k0, int x0, int lane) {
    const int g = lane >> 4, q = (lane & 15) >> 2, p = lane & 3;
    lptr a = tile + (k0 + 8 * g + q) * stride + (x0 + 4 * p) * 2;
    const v4i16_t v0 = __builtin_amdgcn_ds_read_tr16_b64_v4i16((LAS v4i16_t*)a), v1 = __builtin_amdgcn_ds_read_tr16_b64_v4i16((LAS v4i16_t*)(a + 4 * stride));
    return mk8(v0, v1);
}
#define MFMA16(a, b, c) __builtin_amdgcn_mfma_f32_16x16x32_bf16(a, b, c, 0, 0, 0)

DEV void phase_sgu_fast(const Ctx& X, lptr L) {
    const u16* P0 = X.BIG; u16* CAT = X.XN; constexpr int SV = 528;
    const int lane = X.lane, w = X.wave, fi = lane & 15, fg = lane >> 4;
    for (int it = blockIdx.x; it < NPC * 2; it += gridDim.x) {
        const int pc = it >> 1, half = it & 1;
        __syncthreads();
        for (int c = X.tid; c < 128 * 32; c += NTHR) { const int row = c >> 5, ch = c & 31;
            *(LAS u32x4*)(L + row * SV + ch * 16) = *(const u32x4*)(P0 + (size_t)(pc * 128 + row) * EVEN_IN + 512 + half * 256 + ch * 8); }
        __syncthreads();
        const int gl = w >> 1, mh = w & 1, g = half * 4 + gl;
        f32x4 acc[4][4];
#pragma unroll
        for (int a = 0; a < 4; ++a)
#pragma unroll
            for (int b = 0; b < 4; ++b) acc[a][b] = (f32x4){0.f, 0.f, 0.f, 0.f};
        const u16* Wg = X.SPW + (size_t)g * 128 * 128 + (size_t)(64 * mh + fi) * 128 + 8 * fg;
#pragma unroll
        for (int ks = 0; ks < 4; ++ks) {
            bf16x8 af[4], bfr[4];
#pragma unroll
            for (int mt = 0; mt < 4; ++mt) af[mt] = *(const bf16x8*)(Wg + (size_t)(16 * mt) * 128 + 32 * ks);
#pragma unroll
            for (int nt = 0; nt < 4; ++nt) bfr[nt] = tr_frag(L, SV, 32 * ks, gl * 64 + 16 * nt, lane);
#pragma unroll
            for (int mt = 0; mt < 4; ++mt)
#pragma unroll
                for (int nt = 0; nt < 4; ++nt) acc[mt][nt] = MFMA16(af[mt], bfr[nt], acc[mt][nt]);
        }
#pragma unroll
        for (int mt = 0; mt < 4; ++mt)
#pragma unroll
            for (int j = 0; j < 4; ++j) {
                const int t = 64 * mh + 16 * mt + 4 * fg + j; const size_t row = (size_t)pc * 128 + t; const float bias = X.ab_spatial_b[g * 128 + t];
#pragma unroll
                for (int nt = 0; nt < 4; ++nt) { const int col = g * 64 + 16 * nt + fi; CAT[row * D + col] = f2bf(bf2f(P0[row * EVEN_IN + col]) * (acc[mt][nt][j] + bias)); }
            }
    }
}

DEV void phase_m1_fast(const Ctx& X, lptr L) {
    const u16* PM = X.BIG; const u16* QKC = X.XN; constexpr int SV = 272, SK = 144;
    lptr LV = L, LK0 = L + 128 * SV, LK1 = LK0 + 128 * SK;
    const int lane = X.lane, w = X.wave, fi = lane & 15, fg = lane >> 4;
    for (int it = blockIdx.x; it < 8 * NPC; it += gridDim.x) {
        const int h = it / NPC, pc = it % NPC, item0 = item_of(0, h, pc), item1 = item_of(1, h, pc);
        __syncthreads();
        for (int c = X.tid; c < 128 * 16; c += NTHR) { const int row = c >> 4, ch = c & 15;
            *(LAS u32x4*)(LV + row * SV + ch * 16) = *(const u32x4*)(PM + (size_t)(pc * 128 + row) * PMW + 1024 + h * 128 + ch * 8); }
        for (int c = X.tid; c < 128 * 8; c += NTHR) { const int row = c >> 3, ch = c & 7;
            const bf16x8 kv = *(const bf16x8*)(QKC + (size_t)(pc * 128 + row) * D + 512 + h * 64 + ch * 8);
            const float e0 = X.EE[(size_t)item0 * 128 + row], e1 = X.EE[(size_t)item1 * 128 + row];
            float f[8];
#pragma unroll
            for (int j = 0; j < 8; ++j) f[j] = bf2f((u16)kv[j]);
            u32x4 o0, o1;
            o0.x = pk2(f[0] * e0, f[1] * e0); o0.y = pk2(f[2] * e0, f[3] * e0); o0.z = pk2(f[4] * e0, f[5] * e0); o0.w = pk2(f[6] * e0, f[7] * e0);
            o1.x = pk2(f[0] * e1, f[1] * e1); o1.y = pk2(f[2] * e1, f[3] * e1); o1.z = pk2(f[4] * e1, f[5] * e1); o1.w = pk2(f[6] * e1, f[7] * e1);
            *(LAS u32x4*)(LK0 + row * SK + ch * 16) = o0; *(LAS u32x4*)(LK1 + row * SK + ch * 16) = o1; }
        __syncthreads();
        const int d = w >> 2, vq = w & 3, item = d ? item1 : item0; lptr LK = d ? LK1 : LK0;
        f32x4 acc[2][4];
#pragma unroll
        for (int a = 0; a < 2; ++a)
#pragma unroll
            for (int b = 0; b < 4; ++b) acc[a][b] = (f32x4){0.f, 0.f, 0.f, 0.f};
#pragma unroll
        for (int ks = 0; ks < 4; ++ks) {
            bf16x8 af[2], bfr[4];
#pragma unroll
            for (int mt = 0; mt < 2; ++mt) af[mt] = tr_frag(LV, SV, 32 * ks, 32 * vq + 16 * mt, lane);
#pragma unroll
            for (int nt = 0; nt < 4; ++nt) bfr[nt] = tr_frag(LK, SK, 32 * ks, 16 * nt, lane);
#pragma unroll
            for (int mt = 0; mt < 2; ++mt)
#pragma unroll
                for (int nt = 0; nt < 4; ++nt) acc[mt][nt] = MFMA16(af[mt], bfr[nt], acc[mt][nt]);
        }
        float* co = X.CLOC + (size_t)item * 8192;
#pragma unroll
        for (int mt = 0; mt < 2; ++mt)
#pragma unroll
            for (int nt = 0; nt < 4; ++nt)
#pragma unroll
                for (int j = 0; j < 4; ++j) co[(32 * vq + 16 * mt + 4 * fg + j) * 64 + 16 * nt + fi] = acc[mt][nt][j];
        if (X.tid < 128) { const int dd = X.tid >> 6, kk = X.tid & 63; lptr lk = dd ? LK1 : LK0; float s = 0.f;
            for (int p = 0; p < 128; ++p) s += bf2f(*(LAS u16*)(lk + p * SK + kk * 2));
            X.NLOC[(size_t)(dd ? item1 : item0) * 64 + kk] = s; }
    }
}

DEV void phase_m3_fast(const Ctx& X, lptr L) {
    u16* PM = X.BIG; const u16* QKC = X.XN; constexpr int SV = 272, SC = 144, SP = 272;
    lptr LV = L, LC0 = L + 128 * SV, LC1 = LC0 + 128 * SC, LNI = LC1 + 128 * SC  , LP = LNI + 256;
    const int lane = X.lane, w = X.wave, fi = lane & 15, fg = lane >> 4;
    lptr LPw = LP + w * (16 * SP);
    for (int it = blockIdx.x; it < 8 * (NLAT / 128); it += gridDim.x) {
        const int h = it / (NLAT / 128), pc = 2 + it % (NLAT / 128); const size_t r0 = (size_t)pc * 128;
        __syncthreads();
        for (int c = X.tid; c < 128 * 16; c += NTHR) { const int row = c >> 4, ch = c & 15;
            *(LAS u32x4*)(LV + row * SV + ch * 16) = *(const u32x4*)(PM + (r0 + row) * PMW + 1024 + h * 128 + ch * 8); }
        for (int c = X.tid; c < 2 * 128 * 8; c += NTHR) { const int dd = c >> 10, row = (c >> 3) & 127, ch = c & 7;
            const float* src = X.CLOC + (size_t)item_of(dd, h, pc) * 8192 + row * 64 + ch * 8; const f32x4 a = *(const f32x4*)src, b = *(const f32x4*)(src + 4);
            u32x4 o; o.x = pk2(a.x, a.y); o.y = pk2(a.z, a.w); o.z = pk2(b.x, b.y); o.w = pk2(b.z, b.w);
            *(LAS u32x4*)((dd ? LC1 : LC0) + row * SC + ch * 16) = o; }
        if (X.tid < 128) { const int dd = X.tid >> 6, kk = X.tid & 63; *(LAS u16*)(LNI + (dd * 64 + kk) * 2) = f2bf(X.NLOC[(size_t)item_of(dd, h, pc) * 64 + kk]); }
        __syncthreads();
        bf16x8 qf[2];
#pragma unroll
        for (int ks = 0; ks < 2; ++ks) qf[ks] = *(const bf16x8*)(QKC + (r0 + 16 * w + fi) * D + h * 64 + 32 * ks + 8 * fg);
        f32x4 hs[8];
#pragma unroll
        for (int nt = 0; nt < 8; ++nt) hs[nt] = (f32x4){0.f, 0.f, 0.f, 0.f};
#pragma unroll 1
        for (int d = 0; d < 2; ++d) {
            const int item = item_of(d, h, pc);
            const float* bb = X.BB + (size_t)item * 128; const float* li = X.LI + (size_t)item * 128; const float* rm = X.RM + (size_t)item * 128;
            const float m_in = X.MIN[item];
            f32x4 s[8];
#pragma unroll
            for (int nt = 0; nt < 8; ++nt) {
                s[nt] = (f32x4){0.f, 0.f, 0.f, 0.f};
#pragma unroll
                for (int ks = 0; ks < 2; ++ks) { const bf16x8 kf = *(const bf16x8*)(QKC + (r0 + 16 * nt + fi) * D + 512 + h * 64 + 32 * ks + 8 * fg); s[nt] = MFMA16(kf, qf[ks], s[nt]); }
            }
            const int jrow = 16 * w + fi;
            const float mrow = fmaxf(m_in, rm[jrow]), brow = bb[jrow];
#pragma unroll
            for (int nt = 0; nt < 8; ++nt) {
                const int s0 = 16 * nt + 4 * fg; const f32x4 l4 = *(const f32x4*)(li + s0), b4 = *(const f32x4*)(bb + s0);
                float pv[4];
#pragma unroll
                for (int jj = 0; jj < 4; ++jj) { const int sidx = s0 + jj; const bool valid = d == 0 ? (sidx <= jrow) : (sidx >= jrow); pv[jj] = valid ? s[nt][jj] * __expf(l4[jj] - b4[jj] - mrow) : 0.f; }
                u32x2 pw; pw.x = pk2(pv[0], pv[1]); pw.y = pk2(pv[2], pv[3]);
                *(LAS u32x2*)(LPw + fi * SP + s0 * 2) = pw;
            }
            LDS_FENCE(); __syncthreads();
            const float arow = __expf(m_in - mrow);
            bf16x8 aq[2];
#pragma unroll
            for (int ks = 0; ks < 2; ++ks)
#pragma unroll
                for (int e = 0; e < 8; ++e) aq[ks][e] = (short)f2bf(bf2f((u16)qf[ks][e]) * arow);
            f32x4 num[8], den = (f32x4){0.f, 0.f, 0.f, 0.f};
#pragma unroll
            for (int nt = 0; nt < 8; ++nt) num[nt] = (f32x4){0.f, 0.f, 0.f, 0.f};
            const bf16x8 ones = (bf16x8){(short)0x3F80, (short)0x3F80, (short)0x3F80, (short)0x3F80, (short)0x3F80, (short)0x3F80, (short)0x3F80, (short)0x3F80};
#pragma unroll
            for (int ks = 0; ks < 4; ++ks) {
                const bf16x8 pf = *(LAS bf16x8*)(LPw + fi * SP + (32 * ks + 8 * fg) * 2);
#pragma unroll
                for (int nt = 0; nt < 8; ++nt) num[nt] = MFMA16(tr_frag(LV, SV, 32 * ks, 16 * nt, lane), pf, num[nt]);
                den = MFMA16(ones, pf, den);
            }
            lptr LC = d ? LC1 : LC0;
#pragma unroll
            for (int ks = 0; ks < 2; ++ks) {
#pragma unroll
                for (int nt = 0; nt < 8; ++nt) num[nt] = MFMA16(*(LAS bf16x8*)(LC + (16 * nt + fi) * SC + (32 * ks + 8 * fg) * 2), aq[ks], num[nt]);
                const bf16x8 nf = *(LAS bf16x8*)(LNI + (d * 64 + 32 * ks + 8 * fg) * 2);
                den = MFMA16(nf, aq[ks], den);
            }
            {
                const float inv = 1.f / fmaxf(fabsf(den[0]), __expf(-(brow + mrow)));
#pragma unroll
                for (int nt = 0; nt < 8; ++nt) hs[nt] = hs[nt] + num[nt] * inv;
            }
            LDS_FENCE(); __syncthreads();
        }
        {
            float ss = 0.f;
#pragma unroll
            for (int nt = 0; nt < 8; ++nt) ss += (hs[nt][0] * hs[nt][0] + hs[nt][1] * hs[nt][1]) + (hs[nt][2] * hs[nt][2] + hs[nt][3] * hs[nt][3]);
            ss += __shfl_xor(ss, 16); ss += __shfl_xor(ss, 32);
            const float rs = rsqrtf(ss * (1.f / 128) + EPS);
            u16* prow = PM + (r0 + 16 * w + fi) * PMW + h * 128 + 4 * fg;
            const float* gp = X.ml_out_norm_g + h * 128 + 4 * fg;
#pragma unroll
            for (int nt = 0; nt < 8; ++nt) {
                const u32x2 og = *(const u32x2*)(prow + 2048 + 16 * nt); const f32x4 gg = *(const f32x4*)(gp + 16 * nt);
                u32x2 o;
                o.x = pk2(hs[nt][0] * rs * gg[0] * sigmoid_f(bf2f((u16)(og.x & 0xffffu))), hs[nt][1] * rs * gg[1] * sigmoid_f(bf2f((u16)(og.x >> 16))));
                o.y = pk2(hs[nt][2] * rs * gg[2] * sigmoid_f(bf2f((u16)(og.y & 0xffffu))), hs[nt][3] * rs * gg[3] * sigmoid_f(bf2f((u16)(og.y >> 16))));
                *(u32x2*)(prow + 16 * nt) = o;
            }
        }
    }
}

#define XB_TMO      128
#define XB_XCNT(j)  (256  + 64 * (j))
#define XB_XSUB(j)  (1280 + 64 * (j))
#define XB_XGEN(j)  (2304 + 64 * (j))
#define XB_TOP      3328
#define XB_TOPGEN   3392
#define XCD_BAR_WORDS 3456
#define XB_SPIN_CAP (1u << 22)

__device__ __forceinline__ unsigned xb_ld(unsigned* p)              { return __hip_atomic_load(p, __ATOMIC_RELAXED, __HIP_MEMORY_SCOPE_AGENT); }
__device__ __forceinline__ unsigned xb_add(unsigned* p, unsigned v) { return __hip_atomic_fetch_add(p, v, __ATOMIC_RELAXED, __HIP_MEMORY_SCOPE_AGENT); }
__device__ __forceinline__ unsigned xb_xcc_id() { return (unsigned)__builtin_amdgcn_s_getreg((3 << 11) | 20) & 0xFu; }
#define XB_SPIN(cond, bar) do { unsigned _sp = 0; while (cond) { __builtin_amdgcn_s_sleep(1); \
    if ((++_sp & 255u) == 0u) { if (xb_ld(&(bar)[XB_TMO])) break; if (_sp > XB_SPIN_CAP) { atomicAdd(&(bar)[XB_TMO], 1u); break; } } } } while (0)

struct XcdBarrier {
    unsigned* bar; unsigned x;
    volatile LAS unsigned* st;
};

__device__ __forceinline__ XcdBarrier xcd_barrier_post(unsigned* bar, volatile LAS unsigned* st) {
    XcdBarrier b; b.bar = bar; b.x = xb_xcc_id(); b.st = st;
    if (threadIdx.x == 0) (void)xb_add(&bar[XB_XCNT(b.x)], 1u);
    return b;
}
__device__ __forceinline__ void xcd_barrier_complete(unsigned* bar, unsigned x, unsigned& nloc, unsigned& nx) {
    const unsigned G = gridDim.x * gridDim.y * gridDim.z;
    unsigned sum, cnt, mine, sp = 0u;
    for (;;) {
        sum = 0u; cnt = 0u; mine = 0u;
#pragma unroll
        for (unsigned j = 0; j < 16; ++j) { const unsigned c = xb_ld(&bar[XB_XCNT(j)]); sum += c; cnt += (c > 0u) ? 1u : 0u; mine = (j == x) ? c : mine; }
        if (sum == G) break;
        __builtin_amdgcn_s_sleep(1);
        if ((++sp & 255u) == 0u) { if (xb_ld(&bar[XB_TMO])) break; if (sp > XB_SPIN_CAP) { atomicAdd(&bar[XB_TMO], 1u); break; } }
    }
    nloc = mine > 0u ? mine : 1u; nx = cnt > 0u ? cnt : 1u;
}

__device__ __forceinline__ void xcd_barrier(const XcdBarrier& b) {
    asm volatile("s_waitcnt vmcnt(0)" ::: "memory");
    __syncthreads();
    if (threadIdx.x == 0) {
        unsigned* bar = b.bar;
        __builtin_amdgcn_s_waitcnt(0);
        unsigned nloc = b.st[0], nx = b.st[1];
        if (nloc == 0u) { xcd_barrier_complete(bar, b.x, nloc, nx); b.st[0] = nloc; b.st[1] = nx; }
        const unsigned old = xb_add(&bar[XB_XSUB(b.x)], 1u);
        const unsigned gen = old / nloc;
        if (old + 1u == (gen + 1u) * nloc) {
            __builtin_amdgcn_fence(__ATOMIC_RELEASE, "agent");
            asm volatile("s_waitcnt vmcnt(0)" ::: "memory");
            const unsigned og = xb_add(&bar[XB_TOP], 1u);
            const unsigned tg = og / nx;
            if (og + 1u == (tg + 1u) * nx) xb_add(&bar[XB_TOPGEN], 1u);
            else XB_SPIN(xb_ld(&bar[XB_TOPGEN]) == tg, bar);
            __builtin_amdgcn_fence(__ATOMIC_ACQUIRE, "agent");
            xb_add(&bar[XB_XGEN(b.x)], 1u);
            asm volatile("s_waitcnt vmcnt(0)" ::: "memory");
        } else {
            XB_SPIN(xb_ld(&bar[XB_XGEN(b.x)]) == gen, bar);
            __builtin_amdgcn_fence(__ATOMIC_ACQUIRE, "agent");
            asm volatile("s_waitcnt vmcnt(0)" ::: "memory");
        }
    }
    __syncthreads();
}

__global__ void __launch_bounds__(NTHR, 2) fwd_kernel(Args args) {
    extern __shared__ __attribute__((aligned(16))) unsigned char lds[];
    cg::grid_group grid = cg::this_grid();
    Ctx X;
    X.x = args.in[0]; X.c = args.in[1]; X.ctx = args.in[2]; X.c_ctx = args.in[3]; X.mod_w = args.in[4]; X.mod_b = args.in[5]; X.norm_g = args.in[6];
    X.ffn_w13 = args.in[7]; X.ffn_w2 = args.in[8]; X.ab_w_in = args.in[9]; X.ab_gate_norm_g = args.in[10]; X.ab_spatial_w = args.in[11]; X.ab_spatial_b = args.in[12];
    X.ab_q_norm_g = args.in[13]; X.ab_k_norm_g = args.in[14]; X.ab_w_out = args.in[15]; X.ml_w_in = args.in[16]; X.ml_conv_w = args.in[17]; X.ml_gate_b = args.in[18];
    X.ml_out_norm_g = args.in[19]; X.ml_w_out = args.in[20]; X.final_norm_g = args.in[21];
    X.out = args.out; unsigned char* ws = args.ws;
    X.MV = (float*)(ws + WS_MV); X.ROPE = (float*)(ws + WS_MV + 160 * KiB);
    X.MLOC = (float*)(ws + WS_MISC); X.BLAST = X.MLOC + 4096; X.MIN = X.MLOC + 8192; X.NLOC = X.MLOC + 16384;
    X.BB = (float*)(ws + WS_GS); X.LI = X.BB + NITEM * 128; X.EE = X.LI + NITEM * 128; X.RM = X.EE + NITEM * 128;
    X.G = (float*)(ws + WS_G); X.H = (float*)(ws + WS_H); X.CLOC = (float*)(ws + WS_CLOC); X.RAW = (u16*)(ws + WS_CLOC);
    X.W13T = (u16*)(ws + WS_W13T); X.W2T = (u16*)(ws + WS_W2T); X.ABIN = (u16*)(ws + WS_ABIN); X.ABOUT = (u16*)(ws + WS_ABOUT);
    X.MLIN = (u16*)(ws + WS_MLIN); X.MLOUT = (u16*)(ws + WS_MLOUT); X.SPW = (u16*)(ws + WS_SPW); X.XN = (u16*)(ws + WS_XN); X.BIG = (u16*)(ws + WS_BIG);
#define SET_TID() do { X.tid = tid_fresh(); X.lane = X.tid & 63; X.wave = __builtin_amdgcn_readfirstlane(X.tid >> 6); X.gw = blockIdx.x * NWAVES + X.wave; X.gtid = blockIdx.x * NTHR + X.tid; } while (0)
    SET_TID(); X.NGW = gridDim.x * NWAVES; X.NT = gridDim.x * NTHR;
    X.lds = lds;
    const int lo = args.ph_lo, hi = args.ph_hi;
    volatile LAS unsigned* bst = (volatile LAS unsigned*)((lptr)lds + (LDS_BYTES - 64));
    if (X.tid < 2) bst[X.tid] = 0u;
    __syncthreads();
    const XcdBarrier xbar = xcd_barrier_post((unsigned*)(ws + WS_BAR), bst);
    int ph = 0;
#define PH_BEGIN if (lo <= ph && ph < hi) { SET_TID();
#define GSYNC() do { __builtin_amdgcn_fence(__ATOMIC_RELEASE, "agent"); asm volatile("s_waitcnt vmcnt(0) lgkmcnt(0)" ::: "memory"); grid.sync(); \
        __builtin_amdgcn_fence(__ATOMIC_ACQUIRE, "agent"); asm volatile("s_waitcnt vmcnt(0)" ::: "memory"); __syncthreads(); } while (0)
#define PH_END } if (lo <= ph && ph + 1 < hi) { if (lo < 0) grid.sync(); else { xcd_barrier(xbar); if (PROBE_REP & 128) xcd_barrier(xbar); } } ++ph;
    const float* MVL0 = X.MV; const float* MVC0 = X.MV + 9216; const float* MVL1 = X.MV + 2 * 9216; const float* MVC1 = X.MV + 3 * 9216;

    PH_BEGIN REPN(1) { __syncthreads(); phase_prep(X); } PH_END
#define FGEMM(EpiT, epi, Aptr, lda_, Btptr, rows, pm0_, N_, K_) { pg8::Gemm g_{Aptr, lda_, Btptr, K_, rows, N_, K_}; pg8::Order S_; S_.init(rows, N_, (int)gridDim.x, (int)blockIdx.x, pm0_); \
        const EpiT e_ = epi; pg8::gemm_phase<EpiT, pg8::Order, true, true>((PG8_LAS unsigned char*)lds, g_, S_, e_); }
#define NGEMM(site_, mode_, MVOFF_, SHOFF_, NGOFF_, FROM_IN_, MUL2_, ngbase_, Aptr, lda_, Btptr, K_) { pg8::Gemm g_{Aptr, lda_, Btptr, K_, NLAT, D, K_}; pg8::Order S_; S_.init(NLAT, D, (int)gridDim.x, (int)blockIdx.x, 1); \
        typedef EpiResidNorm<mode_, site_, MVOFF_, SHOFF_, NGOFF_, FROM_IN_, MUL2_> EN_; const EN_ e_{ws, ngbase_, X.x, X.out}; \
        pg8::gemm_phase<EN_, pg8::Order, false, true>((PG8_LAS unsigned char*)lds, g_, S_, e_); }
#define KSGEMM(Aptr, lda_, Btptr, ldb_, S_, kc_, mvc_, mul_) { pg8::Gemm g_{Aptr, lda_, Btptr, ldb_, 256, D, kc_}; pg8::OrderKS S2_; S2_.init(D, S_, kc_, (int)gridDim.x, (int)blockIdx.x); \
        const EpiPartial e_{X.CLOC, mvc_, mul_, kc_}; pg8::gemm_phase<EpiPartial, pg8::OrderKS, true, true>((PG8_LAS unsigned char*)lds, g_, S2_, e_); }
#define FFN_UP(idx, rows, pm0_) PH_BEGIN REPN(64) if (FASTG & 1) { FGEMM(EpiSwiGLU, (EpiSwiGLU{X.BIG}), X.XN, D, X.W13T + (size_t)(idx) * F2 * D, rows, pm0_, F2, D) \
            if (PREP_DEFER && (idx) < 3) { const int nwg_ = ((rows) / 256) * (F2 / 256), rem_ = nwg_ % (int)gridDim.x; \
                if (rem_ != 0 && (int)blockIdx.x >= rem_) prep_group(X, (idx) + 1, ((int)blockIdx.x - rem_) * NWAVES + X.wave, ((int)gridDim.x - rem_) * NWAVES); \
                else if (rem_ == 0) prep_group(X, (idx) + 1, X.gw, X.NGW); } } \
        else ngemm<true>(X, X.XN, D, X.W13T + (size_t)(idx) * F2 * D, D, (pm0_) * 256, rows, F2, FSwiglu{X.BIG}); PH_END
#define FFN_DOWN(idx, rows, pm0_, from_in, mvl_, mvc_, site_, mode_, MVOFF_, SHOFF_, NGOFF_, ngbase_) PH_BEGIN if (FASTG & 2) { \
            if (NFUSE) NGEMM(site_, mode_, MVOFF_, SHOFF_, NGOFF_, from_in, 1, ngbase_, X.BIG, FH, X.W2T + (size_t)(idx) * D * FH, FH) \
            else FGEMM(EpiResid, (EpiResid{(from_in) ? X.ctx : X.H, (from_in) ? X.x : X.H + (size_t)NCTX * D, X.H, mvl_, mvc_, 0.5f}), X.BIG, FH, X.W2T + (size_t)(idx) * D * FH, (KSPLIT ? NLAT : rows), (KSPLIT ? 1 : pm0_), D, FH) \
            if (KSPLIT && (pm0_) == 0) KSGEMM(X.BIG, FH, X.W2T + (size_t)(idx) * D * FH, FH, 11, 256, mvc_, 0.5f) \
            } \
        else ngemm<false>(X, X.BIG, FH, X.W2T + (size_t)(idx) * D * FH, FH, (pm0_) * 256, rows, D, FResid{&X, from_in, mvl_, mvc_, 0.5f}); PH_END
    PH_BEGIN REPN(2) phase_norm(X, 0, 0, true, 0); PH_END
    FFN_UP(0, R, 0)
    FFN_DOWN(0, R, 0, true, MVL0 + 2 * D, MVC0 + 2 * D, 0, 0, 2 * D, 3 * D, 1 * D, X.norm_g)
    PH_BEGIN phase_norm(X, 0, 1, false, 0, KSPLIT ? 11 : 0, NFUSE ? NCTX : R); PH_END
    if (FASTG & 4) {
        PH_BEGIN REPN(1024) FGEMM(EpiAB, (EpiAB{X.BIG, X.ab_gate_norm_g, X.ab_q_norm_g, X.ab_k_norm_g, X.ROPE}), X.XN, D, X.ABIN, R, 0, EVEN_IN, D) PH_END
    } else {
        PH_BEGIN ngemm<false>(X, X.XN, D, X.ABIN, D, 0, R, EVEN_IN, FRawAB{X.RAW}); PH_END
        PH_BEGIN phase_abpost(X); PH_END
    }
    PH_BEGIN REPN(4) { if (FASTM & 1) phase_sgu_fast(X, (lptr)lds); else phase_sgu_naive(X);
        __syncthreads();
        if (FASTA) phase_attn_fast(X, (char*)lds); else phase_attn_naive(X); } PH_END
    PH_BEGIN if (FASTG & 8) { if (NFUSE) NGEMM(1, 0, 5 * D, 6 * D, 2 * D, false, 2, X.norm_g, X.XN, D, X.ABOUT, D)
            else FGEMM(EpiResid, (EpiResid{X.H, X.H + (size_t)NCTX * D, X.H, MVL0 + 5 * D, MVC0 + 5 * D, 1.f}), X.XN, D, X.ABOUT, (KSPLIT ? NLAT : R), (KSPLIT ? 1 : 0), D, D)
            if (KSPLIT) KSGEMM(X.XN, D, X.ABOUT, D, 4, 256, MVC0 + 5 * D, 1.f) }
        else ngemm<false>(X, X.XN, D, X.ABOUT, D, 0, R, D, FResid{&X, false, MVL0 + 5 * D, MVC0 + 5 * D, 1.f}); PH_END
    PH_BEGIN phase_norm(X, 0, 2, false, 0, KSPLIT ? 4 : 0, NFUSE ? NCTX : R); PH_END
    FFN_UP(1, R, 0)
    FFN_DOWN(1, R, 0, false, MVL0 + 8 * D, MVC0 + 8 * D, 2, 0, 8 * D, 2 * 9216, 3 * D, X.norm_g)
    PH_BEGIN phase_norm(X, 1, 0, false, 0, KSPLIT ? 11 : 0, NFUSE ? NCTX : R); PH_END
    FFN_UP(2, R, 0)
    FFN_DOWN(2, R, 0, false, MVL1 + 2 * D, MVC1 + 2 * D, 3, 0, 2 * 9216 + 2 * D, 2 * 9216 + 3 * D, 4 * D, X.norm_g)
    PH_BEGIN phase_norm(X, 1, 1, false, 0, KSPLIT ? 11 : 0, NFUSE ? NCTX : R); PH_END
    PH_BEGIN REPN(1024) if (FASTG & 16) FGEMM(EpiML, (EpiML{X.BIG, X.G, X.ml_gate_b}), X.XN, D, X.MLIN, R, 0, ODD_PAD, D)
        else ngemm<false>(X, X.XN, D, X.MLIN, D, 0, R, ODD_PAD, FML{X.BIG, X.G, X.ml_gate_b}); PH_END
    PH_BEGIN REPN(8) phase_x1(X); PH_END
    for (int rr_ = 0; rr_ < ((PROBE_REP & 256) ? 2 : 1); ++rr_) {
    PH_BEGIN REPN(16) { if (FASTM & 2) phase_m1_fast(X, (lptr)lds); else phase_m1_naive(X); } PH_END
    PH_BEGIN phase_m2(X); PH_END
    }
    if (FASTM & 4) { PH_BEGIN REPN(32) phase_m3_fast(X, (lptr)lds); PH_END }
    else { PH_BEGIN phase_m3_naive(X); PH_END
    PH_BEGIN phase_m3post(X); PH_END }
    PH_BEGIN if (FASTG & 8) { if (NFUSE) NGEMM(4, 0, 2 * 9216 + 5 * D, 2 * 9216 + 6 * D, 5 * D, false, 2, X.norm_g, X.BIG, PMW, X.MLOUT, D)
            else FGEMM(EpiResid, (EpiResid{X.H, X.H + (size_t)NCTX * D, X.H, MVL1 + 5 * D, MVC1 + 5 * D, 1.f}), X.BIG, PMW, X.MLOUT, NLAT, 1, D, D) }
        else ngemm<false>(X, X.BIG, PMW, X.MLOUT, D, NCTX, NLAT, D, FResid{&X, false, MVL1 + 5 * D, MVC1 + 5 * D, 1.f}); PH_END
    if (!NFUSE) { PH_BEGIN REPN(2) phase_norm(X, 1, 2, false, NCTX); PH_END }
    FFN_UP(3, NLAT, 1)
    FFN_DOWN(3, NLAT, 1, false, MVL1 + 8 * D, MVC1 + 8 * D, 5, 1, 2 * 9216 + 8 * D, 0, 0, X.final_norm_g)
    if (!NFUSE) { PH_BEGIN phase_final(X); PH_END }
}
constexpr int N_PHASES = 27 - ((FASTG & 4) ? 1 : 0) - ((FASTM & 4) ? 1 : 0) + ((PROBE_REP & 256) ? 2 : 0) - (NFUSE ? 2 : 0);

extern "C" void kernel_launch(void* const* d_in, const int* in_sizes, int n_in, void* d_out, int out_size, void* d_ws, size_t ws_size, hipStream_t stream) {
    static int grid = 0;
    if (grid == 0) {
        if (n_in != 22 || ws_size < WS_RSS + WS_RSS_BYTES) { fprintf(stderr, "kernel_launch: unexpected n_in %d / ws_size %zu (need %zu)\n", n_in, ws_size, (size_t)WS_END); grid = -1; return; }
        int dev = 0, cus = 0, per_cu = 0;
        (void)hipGetDevice(&dev); (void)hipDeviceGetAttribute(&cus, hipDeviceAttributeMultiprocessorCount, dev);
        (void)hipFuncSetAttribute((const void*)fwd_kernel, hipFuncAttributeMaxDynamicSharedMemorySize, LDS_BYTES);
        (void)hipOccupancyMaxActiveBlocksPerMultiprocessor(&per_cu, (const void*)fwd_kernel, NTHR, LDS_BYTES);
        if (per_cu < 1) per_cu = 1;
        grid = cus * per_cu;
        (void)hipGetLastError();
    }
    if (grid < 0) return;
    (void)hipMemsetAsync((char*)d_ws + WS_BAR, 0, 48 * KiB, stream);
    if (NFUSE) (void)hipMemsetAsync((char*)d_ws + WS_RSS, 0, WS_RSS_BYTES, stream);
    Args a{};
    for (int i = 0; i < 22; ++i) a.in[i] = (const float*)d_in[i];
    a.out = (float*)d_out; a.ws = (unsigned char*)d_ws; a.ph_lo = 0; a.ph_hi = N_PHASES;
    void* kargs[] = {&a};
    hipError_t e = hipLaunchCooperativeKernel((const void*)fwd_kernel, dim3(grid), dim3(NTHR), kargs, LDS_BYTES, stream);
    if (e != hipSuccess) fprintf(stderr, "cooperative launch failed: %s (grid %d)\n", hipGetErrorString(e), grid);
}
```
